# Optimizing an MI355X kernel written in HIP

```python
import jax
import jax.numpy as jnp
from jax import lax
import numpy as np

D_MODEL = 2048
BATCH = 1
SEQ = 16384
DEPTH = 1

EPS = 1e-6

ATTN_Q_HEADS = 8
ATTN_KV_HEADS = 2
ATTN_HEAD_DIM = 128
ATTN_GROUP = ATTN_Q_HEADS // ATTN_KV_HEADS
WINDOW = 128
ATTN_BLOCK = 128
ROPE_THETA = 500000.0
ROPE_DIM = ATTN_HEAD_DIM // 4
ATTN_WIDTH = ATTN_Q_HEADS * ATTN_HEAD_DIM

GLA_HEADS = 4
GLA_DK = 128
GLA_DV = 256
GLA_GATE_RANK = 16
GLA_GATE_TAU = 16.0
GLA_CHUNK = 64
GLA_WIDTH = GLA_HEADS * GLA_DV

MIX_WIDTH = ATTN_WIDTH + GLA_WIDTH

IN_SPLIT_SIZES = (ATTN_WIDTH, ATTN_KV_HEADS * ATTN_HEAD_DIM, ATTN_KV_HEADS * ATTN_HEAD_DIM,
                  GLA_HEADS * GLA_DK, GLA_HEADS * GLA_DK, GLA_WIDTH, GLA_WIDTH,
                  GLA_GATE_RANK, GLA_GATE_RANK)
IN_WIDTH = sum(IN_SPLIT_SIZES)
IN_SPLIT_POINTS = tuple(int(v) for v in np.cumsum(IN_SPLIT_SIZES)[:-1])

N_GROUPS = 4
EXPERTS_PER_GROUP = 8
N_EXPERTS = N_GROUPS * EXPERTS_PER_GROUP
TOP_K = 2
D_FF_EXPERT = 1024
MOE_BLOCK = 128

kernel_name = 'hymba_swa_gla_hier_moe'


def rmsnorm(x, w):
    xf = x.astype(jnp.float32)
    y = xf * lax.rsqrt(jnp.mean(xf * xf, axis=-1, keepdims=True) + EPS)
    return (y * w.astype(jnp.float32)).astype(x.dtype)


def partial_rope(x, pos):
    half = ROPE_DIM // 2
    inv_freq = jnp.power(jnp.float32(ROPE_THETA), -jnp.arange(half, dtype=jnp.float32) * (2.0 / ROPE_DIM))
    ang = pos.astype(jnp.float32)[:, None] * inv_freq[None, :]
    cos = jnp.cos(ang)[None, :, None, :]
    sin = jnp.sin(ang)[None, :, None, :]
    xf = x.astype(jnp.float32)
    x1 = xf[..., :half]
    x2 = xf[..., half:ROPE_DIM]
    out = jnp.concatenate([x1 * cos - x2 * sin, x2 * cos + x1 * sin, xf[..., ROPE_DIM:]], axis=-1)
    return out.astype(x.dtype)


def windowed_gqa(q, k, v, sink):
    B, S = q.shape[0], q.shape[1]
    nb = S // ATTN_BLOCK
    qb = q.reshape(B, nb, ATTN_BLOCK, ATTN_KV_HEADS, ATTN_GROUP, ATTN_HEAD_DIM)

    def band(t):
        tp = jnp.pad(t, ((0, 0), (ATTN_BLOCK, ATTN_BLOCK), (0, 0), (0, 0)))
        tp = tp.reshape(B, nb + 2, ATTN_BLOCK, ATTN_KV_HEADS, ATTN_HEAD_DIM)
        return jnp.concatenate([tp[:, :-2], tp[:, 1:-1], tp[:, 2:]], axis=2)

    kb = band(k)
    vb = band(v)
    s = jnp.einsum('bnqhgd,bnkhd->bnhgqk', qb, kb,
                   preferred_element_type=jnp.float32) * (ATTN_HEAD_DIM ** -0.5)
    blk = jnp.arange(nb)
    qpos = blk[:, None] * ATTN_BLOCK + jnp.arange(ATTN_BLOCK)[None, :]
    kpos = (blk[:, None] - 1) * ATTN_BLOCK + jnp.arange(3 * ATTN_BLOCK)[None, :]
    rel = kpos[:, None, :] - qpos[:, :, None]
    valid = (jnp.abs(rel) <= WINDOW) & (kpos[:, None, :] >= 0) & (kpos[:, None, :] < S)
    s = jnp.where(valid[None, :, None, None], s, -jnp.inf)
    sink_col = jnp.broadcast_to(
        sink.astype(jnp.float32).reshape(1, 1, ATTN_KV_HEADS, ATTN_GROUP, 1, 1), s.shape[:-1] + (1,))
    p = jax.nn.softmax(jnp.concatenate([s, sink_col], axis=-1), axis=-1)[..., :-1]
    o = jnp.einsum('bnhgqk,bnkhd->bnqhgd', p.astype(v.dtype), vb)
    return o.reshape(B, S, ATTN_WIDTH)


def gla_chunked(q, k, v, log_a):
    B, S, H, dk = q.shape
    dv = v.shape[-1]
    n = S // GLA_CHUNK

    def chunks(t):
        return t.reshape(B, n, GLA_CHUNK, H, t.shape[-1]).transpose(0, 3, 1, 2, 4).astype(jnp.float32)

    q, k, v, log_a = chunks(q), chunks(k), chunks(v), chunks(log_a)
    b = jnp.cumsum(log_a, axis=-2)
    q_dec = q * jnp.exp(b)
    k_inv = k * jnp.exp(-b)
    k_end = k * jnp.exp(b[..., -1:, :] - b)
    tri = jnp.tril(jnp.ones((GLA_CHUNK, GLA_CHUNK), dtype=bool))
    att = jnp.where(tri, jnp.einsum('bhncd,bhnjd->bhncj', q_dec, k_inv), 0.0)
    o_intra = jnp.einsum('bhncj,bhnjv->bhncv', att, v)
    d_state = jnp.einsum('bhncd,bhncv->bhndv', k_end, v)
    chunk_decay = jnp.exp(b[..., -1, :])

    def step(state, inp):
        decay_n, ds_n = inp
        return decay_n[..., None] * state + ds_n, state

    state0 = jnp.zeros((B, H, dk, dv), jnp.float32)
    _, s_in = lax.scan(step, state0, (jnp.moveaxis(chunk_decay, 2, 0), jnp.moveaxis(d_state, 2, 0)))
    s_in = jnp.moveaxis(s_in, 0, 2)
    o = o_intra + jnp.einsum('bhncd,bhndv->bhncv', q_dec, s_in)
    return o.transpose(0, 2, 3, 1, 4).reshape(B, S, H, dv)


def gla_bidirectional(q, k, v, r, lr_f, lr_b, up_f, bias_f, up_b, bias_b, out_norm_w):
    B, S = q.shape[0], q.shape[1]
    q = q.reshape(B, S, GLA_HEADS, GLA_DK) * (GLA_DK ** -0.5)
    k = k.reshape(B, S, GLA_HEADS, GLA_DK)
    v = v.reshape(B, S, GLA_HEADS, GLA_DV)

    def log_gate(lr, up, bias):
        g = jnp.einsum('bsr,rc->bsc', lr, up) + bias
        return (jax.nn.log_sigmoid(g.astype(jnp.float32)) / GLA_GATE_TAU).reshape(B, S, GLA_HEADS, GLA_DK)

    flip = lambda t: jnp.flip(t, axis=1)
    o_f = gla_chunked(q, k, v, log_gate(lr_f, up_f, bias_f))
    o_b = flip(gla_chunked(flip(q), flip(k), flip(v), flip(log_gate(lr_b, up_b, bias_b))))
    o = rmsnorm(o_f + o_b, out_norm_w).reshape(B, S, GLA_WIDTH)
    return (o * jax.nn.silu(r.astype(jnp.float32))).astype(r.dtype)


def hybrid_mixer(x, ln_w, w_in, q_norm_w, k_norm_w, sink, attn_norm_w,
                 gate_up_f, gate_bias_f, gate_up_b, gate_bias_b, gla_norm_w, w_out):
    B, S, _ = x.shape
    xn = rmsnorm(x, ln_w)
    proj = xn @ w_in
    aq, ak, av, gq, gk, gv, gr, lrf, lrb = jnp.split(proj, IN_SPLIT_POINTS, axis=-1)
    pos = jnp.arange(S)
    aq = partial_rope(rmsnorm(aq.reshape(B, S, ATTN_Q_HEADS, ATTN_HEAD_DIM), q_norm_w), pos)
    ak = partial_rope(rmsnorm(ak.reshape(B, S, ATTN_KV_HEADS, ATTN_HEAD_DIM), k_norm_w), pos)
    av = av.reshape(B, S, ATTN_KV_HEADS, ATTN_HEAD_DIM)
    attn = rmsnorm(windowed_gqa(aq, ak, av, sink), attn_norm_w)
    gla = gla_bidirectional(gq, gk, gv, gr, lrf, lrb, gate_up_f, gate_bias_f,
                            gate_up_b, gate_bias_b, gla_norm_w)
    mixed = jnp.concatenate([attn, gla.astype(attn.dtype)], axis=-1)
    return x + mixed @ w_out


def routed_experts(xn, expert_id, weights, w_gate, w_up, w_down):
    T, D = xn.shape
    A = T * TOP_K
    flat_e = expert_id.reshape(A)
    flat_tok = jnp.repeat(jnp.arange(T, dtype=jnp.int32), TOP_K)
    flat_w = weights.reshape(A).astype(jnp.float32)
    counts = jnp.bincount(flat_e, length=N_EXPERTS)
    padded = (counts + MOE_BLOCK - 1) // MOE_BLOCK * MOE_BLOCK
    pad_end = jnp.cumsum(padded)
    pad_start = pad_end - padded
    start = jnp.cumsum(counts) - counts
    order = jnp.argsort(flat_e)
    sorted_e = flat_e[order]
    slot = pad_start[sorted_e] + jnp.arange(A) - start[sorted_e]
    n_blocks = -(-A // MOE_BLOCK) + N_EXPERTS
    n_slots = n_blocks * MOE_BLOCK
    slot_tok = jnp.zeros((n_slots,), jnp.int32).at[slot].set(flat_tok[order])
    slot_w = jnp.zeros((n_slots,), jnp.float32).at[slot].set(flat_w[order])
    block_e = jnp.minimum(jnp.searchsorted(pad_end, jnp.arange(n_blocks) * MOE_BLOCK, side='right'),
                          N_EXPERTS - 1)
    xs = xn[slot_tok].reshape(n_blocks, MOE_BLOCK, D)

    def expert_block(args):
        xb, e = args
        hid = jax.nn.silu(xb @ w_gate[e]) * (xb @ w_up[e])
        return hid @ w_down[e]

    ys = lax.map(expert_block, (xs, block_e)).reshape(n_slots, D)
    ys = ys * slot_w[:, None].astype(ys.dtype)
    return jnp.zeros((T, D), ys.dtype).at[slot_tok].add(ys)


def hier_moe(h, ln_w, w_group, b_group, w_router, b_router, w_gate, w_up, w_down):
    B, S, D = h.shape
    T = B * S
    xn = rmsnorm(h, ln_w).reshape(T, D)
    group_logits = (xn @ w_group).astype(jnp.float32) + b_group.astype(jnp.float32)
    group_p = jax.nn.softmax(group_logits, axis=-1)
    g_sel = jnp.argmax(group_logits, axis=-1)
    g_gate = jnp.take_along_axis(group_p, g_sel[:, None], axis=-1)
    e_logits = ((xn @ w_router).astype(jnp.float32) + b_router.astype(jnp.float32)).reshape(
        T, N_GROUPS, EXPERTS_PER_GROUP)
    in_group = jnp.take_along_axis(e_logits, g_sel[:, None, None], axis=1)[:, 0]
    top_vals, top_idx = lax.top_k(in_group, TOP_K)
    weights = g_gate * jax.nn.softmax(top_vals, axis=-1)
    expert_id = g_sel[:, None].astype(jnp.int32) * EXPERTS_PER_GROUP + top_idx.astype(jnp.int32)
    y = routed_experts(xn, expert_id, weights, w_gate, w_up, w_down)
    return h + y.reshape(B, S, D).astype(h.dtype)


def setup_inputs(seed: int = 0) -> dict:
    key = jax.random.key(seed)
    ks = jax.random.split(key, 21)
    f32 = jnp.float32
    nrm = lambda k, shape, scale: jax.random.normal(k, shape, f32) * scale
    gain = lambda k, shape: 1.0 + 0.02 * jax.random.normal(k, shape, f32)
    return {
        'x': nrm(ks[0], (BATCH, SEQ, D_MODEL), 1.0),
        'ln1_w': gain(ks[1], (DEPTH, D_MODEL)),
        'w_in': nrm(ks[2], (DEPTH, D_MODEL, IN_WIDTH), D_MODEL ** -0.5),
        'q_norm_w': gain(ks[3], (DEPTH, ATTN_HEAD_DIM)),
        'k_norm_w': gain(ks[4], (DEPTH, ATTN_HEAD_DIM)),
        'attn_sink': nrm(ks[5], (DEPTH, ATTN_Q_HEADS), 0.5),
        'attn_out_norm_w': gain(ks[6], (DEPTH, ATTN_WIDTH)),
        'gla_gate_up_f': nrm(ks[7], (DEPTH, GLA_GATE_RANK, GLA_HEADS * GLA_DK), GLA_GATE_RANK ** -0.5),
        'gla_gate_bias_f': nrm(ks[8], (DEPTH, GLA_HEADS * GLA_DK), 0.02),
        'gla_gate_up_b': nrm(ks[9], (DEPTH, GLA_GATE_RANK, GLA_HEADS * GLA_DK), GLA_GATE_RANK ** -0.5),
        'gla_gate_bias_b': nrm(ks[10], (DEPTH, GLA_HEADS * GLA_DK), 0.02),
        'gla_out_norm_w': gain(ks[11], (DEPTH, GLA_DV)),
        'w_out': nrm(ks[12], (DEPTH, MIX_WIDTH, D_MODEL), MIX_WIDTH ** -0.5),
        'ln2_w': gain(ks[13], (DEPTH, D_MODEL)),
        'w_group': nrm(ks[14], (DEPTH, D_MODEL, N_GROUPS), D_MODEL ** -0.5),
        'b_group': nrm(ks[15], (DEPTH, N_GROUPS), 0.01),
        'w_router': nrm(ks[16], (DEPTH, D_MODEL, N_EXPERTS), D_MODEL ** -0.5),
        'b_router': nrm(ks[17], (DEPTH, N_EXPERTS), 0.01),
        'w_gate_e': nrm(ks[18], (DEPTH, N_EXPERTS, D_MODEL, D_FF_EXPERT), D_MODEL ** -0.5),
        'w_up_e': nrm(ks[19], (DEPTH, N_EXPERTS, D_MODEL, D_FF_EXPERT), D_MODEL ** -0.5),
        'w_down_e': nrm(ks[20], (DEPTH, N_EXPERTS, D_FF_EXPERT, D_MODEL), D_FF_EXPERT ** -0.5),
    }


def reference(x, ln1_w, w_in, q_norm_w, k_norm_w, attn_sink, attn_out_norm_w,
              gla_gate_up_f, gla_gate_bias_f, gla_gate_up_b, gla_gate_bias_b, gla_out_norm_w,
              w_out, ln2_w, w_group, b_group, w_router, b_router, w_gate_e, w_up_e, w_down_e):
    h = x
    for l in range(DEPTH):
        h = hybrid_mixer(h, ln1_w[l], w_in[l], q_norm_w[l], k_norm_w[l], attn_sink[l],
                         attn_out_norm_w[l], gla_gate_up_f[l], gla_gate_bias_f[l],
                         gla_gate_up_b[l], gla_gate_bias_b[l], gla_out_norm_w[l], w_out[l])
        h = hier_moe(h, ln2_w[l], w_group[l], b_group[l], w_router[l], b_router[l],
                     w_gate_e[l], w_up_e[l], w_down_e[l])
    return h
```

```cpp
#include <hip/hip_runtime.h>
#include <cstdio>
#include <cstdint>

#ifndef MK_STAGE
#define MK_STAGE 3
#endif

constexpr int S_ = 16384, DM = 2048;
constexpr int PROJ_LD = 4864;
constexpr int C_AQ = 0, C_AK = 1024, C_AV = 1280, C_GQ = 1536, C_GK = 2048, C_GV = 2560, C_GR = 3584, C_LRF = 4608, C_LRB = 4624, IN_W = 4640;
constexpr float EPS_ = 1e-6f;
constexpr int NE = 32, DFF = 1024;
constexpr int P_XS = 2048 + 128, P_HID = 1024 + 128;
constexpr int MAX_TILES = 160, MAX_SLOTS = MAX_TILES * 256;

__device__ __forceinline__ int opaque_tid() { int t = threadIdx.x; asm volatile("" : "+v"(t)); return t; }
namespace pg8 {
#define PG8_LAS __attribute__((address_space(3)))
typedef unsigned short bf16_t;
typedef short bf16x8 __attribute__((ext_vector_type(8)));
typedef float f32x4 __attribute__((ext_vector_type(4)));
typedef unsigned u32x4 __attribute__((ext_vector_type(4)));
constexpr int BM = 256, BK = 64, HALF = 128, HTB = HALF * BK * 2, STAGE_BYTES = 8 * HTB, NXCD = 8, WGM = 8;

__host__ __device__ __forceinline__ int lds_byte(int r, int c) { const int st = (r >> 4) * 2 + (c >> 5), rr = r & 15, cc = c & 31, ob = rr * 64 + cc * 2; return st * 1024 + (ob ^ (((ob >> 9) & 1) << 5)); }
__host__ __device__ __forceinline__ void stage_rc(int b, int& R, int& C) { const int st = b / 1024, sb = b % 1024, swz = sb ^ (((sb >> 9) & 1) << 5); R = (st >> 1) * 16 + swz / 64; C = (st & 1) * 32 + (swz % 64) / 2; }
__host__ __device__ __forceinline__ int perm32(int rho) { const int n = rho >> 4, i = rho & 15; return 8 * (i >> 2) + 4 * n + (i & 3); }

typedef int v4i_q __attribute__((ext_vector_type(4)));
struct Unit { int pm, pn, pb; };
struct Gemm { const void* A; const void* Bt; int Kb; int pa, pb, ka, kb; size_t ta, tb; };

struct StaticOrder {
    int nM, nN, nwg, G, c;
    __device__ void init(int M, int N, int G_, int c_) { nM = M / BM; nN = N / BM; nwg = nM * nN; G = G_; c = c_; }
    __device__ bool next(int i, Unit& u) const {
        const long L = (long)i * G + c; if (L >= nwg) return false;
        int wgid = (int)L; { const int q = nwg / NXCD, r = nwg % NXCD, xcd = wgid % NXCD, off = wgid / NXCD; wgid = (xcd < r ? xcd * (q + 1) : r * (q + 1) + (xcd - r) * q) + off; }
        const int nig = WGM * nN, gid = wgid / nig, fm = gid * WGM, gsz = (nM - fm) < WGM ? (nM - fm) : WGM;
        u.pm = fm + ((wgid % nig) % gsz); u.pn = (wgid % nig) / gsz; u.pb = u.pn; return true;
    }
};
struct MoeOrder {
    int nM, nN, nwg, G, c; const PG8_LAS int* tile_e;
    __device__ void init(int nM_, int nN_, int G_, int c_, const PG8_LAS int* te) { nM = nM_; nN = nN_; nwg = nM * nN; G = G_; c = c_; tile_e = te; }
    __device__ bool next(int i, Unit& u) const {
        const long L = (long)i * G + c; if (L >= nwg) return false;
        int wgid = (int)L; { const int q = nwg / NXCD, r = nwg % NXCD, xcd = wgid % NXCD, off = wgid / NXCD; wgid = (xcd < r ? xcd * (q + 1) : r * (q + 1) + (xcd - r) * q) + off; }
        const int nig = WGM * nN, gid = wgid / nig, fm = gid * WGM, gsz = (nM - fm) < WGM ? (nM - fm) : WGM;
        u.pm = fm + ((wgid % nig) % gsz); u.pn = (wgid % nig) / gsz; u.pb = tile_e[u.pm] * nN + u.pn; return true;
    }
};

__device__ __forceinline__ unsigned cvt_pk_bf16(float lo, float hi) { unsigned r; asm volatile("v_cvt_pk_bf16_f32 %0, %1, %2" : "=v"(r) : "v"(lo), "v"(hi)); return r; }

struct EpiBf16Q {
    static constexpr bool PERM = true;
    bf16_t* O; int ldc;
    __device__ __forceinline__ void operator()(const f32x4 (&acc)[2][2][4][2], const Unit& u, int wr, int wc, int fr, int fq, const PG8_LAS unsigned* ut) const {
        const int row0 = u.pm * BM + wr * 64 + fr, col0 = u.pn * BM + wc * 32 + 8 * fq;
        f32x4 cs[2][2];
#pragma unroll
        for (int bj = 0; bj < 2; ++bj)
#pragma unroll
            for (int n = 0; n < 2; ++n) cs[bj][n] = *(const PG8_LAS f32x4*)(ut + 256 + wc * 32 + 8 * fq + bj * HALF + 4 * n);
        float sav[2][4];
#pragma unroll
        for (int ai = 0; ai < 2; ++ai)
#pragma unroll
            for (int m = 0; m < 4; ++m) sav[ai][m] = __builtin_bit_cast(float, ut[wr * 64 + fr + ai * HALF + m * 16]);
#pragma unroll
        for (int ai = 0; ai < 2; ++ai)
#pragma unroll
            for (int m = 0; m < 4; ++m) { const int row = row0 + ai * HALF + m * 16; const float s = sav[ai][m]; bf16_t* rowp = O + (size_t)row * ldc + col0;
#pragma unroll
                for (int bj = 0; bj < 2; ++bj) { const v4i_q i0 = __builtin_bit_cast(v4i_q, acc[ai][bj][m][0]), i1 = __builtin_bit_cast(v4i_q, acc[ai][bj][m][1]);
                    const f32x4 v0 = __builtin_convertvector(i0, f32x4) * cs[bj][0] * s, v1 = __builtin_convertvector(i1, f32x4) * cs[bj][1] * s;
                    u32x4 w; w.x = cvt_pk_bf16(v0[0], v0[1]); w.y = cvt_pk_bf16(v0[2], v0[3]); w.z = cvt_pk_bf16(v1[0], v1[1]); w.w = cvt_pk_bf16(v1[2], v1[3]);
                    *(u32x4*)(rowp + bj * HALF) = w; } }
    }
};
struct EpiResBf16Q {
    static constexpr bool PERM = true;
    bf16_t* H; const float* R; int ldc; const float* sa; const float* cmax;
    __device__ __forceinline__ void operator()(const f32x4 (&acc)[2][2][4][2], const Unit& u, int wr, int wc, int fr, int fq, const PG8_LAS unsigned*) const {
        const int row0 = u.pm * BM + wr * 64 + fr, col0 = u.pn * BM + wc * 32 + 8 * fq;
        f32x4 cs[2][2];
#pragma unroll
        for (int bj = 0; bj < 2; ++bj)
#pragma unroll
            for (int n = 0; n < 2; ++n) cs[bj][n] = *(const f32x4*)(cmax + col0 + bj * HALF + 4 * n) * (1.f / 127.f);
        float sav[2][4];
#pragma unroll
        for (int ai = 0; ai < 2; ++ai)
#pragma unroll
            for (int m = 0; m < 4; ++m) sav[ai][m] = sa[row0 + ai * HALF + m * 16];
#pragma unroll
        for (int ai = 0; ai < 2; ++ai)
#pragma unroll
            for (int m = 0; m < 4; ++m) { const int row = row0 + ai * HALF + m * 16; const float s = sav[ai][m]; const size_t ro = (size_t)row * ldc + col0;
#pragma unroll
                for (int bj = 0; bj < 2; ++bj) { const f32x4 r0 = __builtin_nontemporal_load((const f32x4*)(R + ro + bj * HALF)), r1 = __builtin_nontemporal_load((const f32x4*)(R + ro + bj * HALF + 4));
                    const v4i_q i0 = __builtin_bit_cast(v4i_q, acc[ai][bj][m][0]), i1 = __builtin_bit_cast(v4i_q, acc[ai][bj][m][1]);
                    const f32x4 v0 = __builtin_convertvector(i0, f32x4) * cs[bj][0] * s + r0, v1 = __builtin_convertvector(i1, f32x4) * cs[bj][1] * s + r1;
                    u32x4 w; w.x = cvt_pk_bf16(v0[0], v0[1]); w.y = cvt_pk_bf16(v0[2], v0[3]); w.z = cvt_pk_bf16(v1[0], v1[1]); w.w = cvt_pk_bf16(v1[2], v1[3]);
                    *(u32x4*)(H + ro + bj * HALF) = w; } }
    }
};
__device__ __forceinline__ float silu_f(float g) { return g * __builtin_amdgcn_rcpf(1.f + __builtin_amdgcn_exp2f(-1.4426950408889634f * g)); }
__device__ __forceinline__ unsigned pk4_fp8(float a, float b, float c, float d) { int w = 0; w = __builtin_amdgcn_cvt_pk_fp8_f32(a, b, w, false); w = __builtin_amdgcn_cvt_pk_fp8_f32(c, d, w, true); return (unsigned)w; }
constexpr float WSCALE = 64.f, WUNSCALE = 1.f / 64.f;
struct EpiSwiGLU {
    static constexpr bool PERM = true;
    unsigned char* H;
    __device__ __forceinline__ void operator()(const f32x4 (&acc)[2][2][4][2], const Unit& u, int wr, int wc, int fr, int fq, const PG8_LAS unsigned* ut) const {
        const int row0 = u.pm * BM + wr * 64 + fr, col0 = u.pn * HALF + wc * 32 + 8 * fq;
        float rsv[2][4];
#pragma unroll
        for (int ai = 0; ai < 2; ++ai)
#pragma unroll
            for (int m = 0; m < 4; ++m) rsv[ai][m] = __builtin_bit_cast(float, ut[wr * 64 + fr + ai * HALF + m * 16]);
#pragma unroll
        for (int ai = 0; ai < 2; ++ai)
#pragma unroll
            for (int m = 0; m < 4; ++m) { const int row = row0 + ai * HALF + m * 16; const float r = rsv[ai][m] * WUNSCALE;
                float h[8];
#pragma unroll
                for (int n = 0; n < 2; ++n)
#pragma unroll
                    for (int e = 0; e < 4; ++e) h[n * 4 + e] = silu_f(acc[ai][0][m][n][e] * r) * (acc[ai][1][m][n][e] * r);
                unsigned w0 = pk4_fp8(h[0], h[1], h[2], h[3]), w1 = pk4_fp8(h[4], h[5], h[6], h[7]);
                typedef unsigned u32x2_t __attribute__((ext_vector_type(2)));
                *(u32x2_t*)(H + (size_t)u.pm * (256 * DFF) + (size_t)u.pn * 32768 + (row & 255) * 128 + wc * 32 + 8 * fq) = (u32x2_t){w0, w1}; }
    }
};
constexpr float YSCALE = 16.f, YUNSCALE = 1.f / 16.f;
struct EpiMoeOut {
    static constexpr bool PERM = true;
    unsigned char* Y;
    __device__ __forceinline__ void operator()(const f32x4 (&acc)[2][2][4][2], const Unit& u, int wr, int wc, int fr, int fq, const PG8_LAS unsigned* ut) const {
        const int row0 = u.pm * BM + wr * 64 + fr, col0 = u.pn * BM + wc * 64 + 16 * fq;
        int dv[2][4]; float wv[2][4];
#pragma unroll
        for (int ai = 0; ai < 2; ++ai)
#pragma unroll
            for (int m = 0; m < 4; ++m) { const int rl = wr * 64 + fr + ai * HALF + m * 16; dv[ai][m] = (int)ut[rl]; wv[ai][m] = __builtin_bit_cast(float, ut[256 + rl]); }
#pragma unroll
        for (int ai = 0; ai < 2; ++ai)
#pragma unroll
            for (int m = 0; m < 4; ++m) { const int d = dv[ai][m]; const float ww = wv[ai][m] * (WUNSCALE * YSCALE);
                if (d >= 0) { const f32x4 v0 = acc[ai][0][m][0] * ww, v1 = acc[ai][0][m][1] * ww, v2 = acc[ai][1][m][0] * ww, v3 = acc[ai][1][m][1] * ww;
                    *(u32x4*)(Y + (size_t)d * DM + col0) = (u32x4){pk4_fp8(v0[0], v0[1], v0[2], v0[3]), pk4_fp8(v1[0], v1[1], v1[2], v1[3]), pk4_fp8(v2[0], v2[1], v2[2], v2[3]), pk4_fp8(v3[0], v3[1], v3[2], v3[3])}; } }
    }
};

typedef int v4i_t __attribute__((ext_vector_type(4)));
typedef int v8i_t __attribute__((ext_vector_type(8)));
template <class Epi, class Sched, int MODE = 0, bool GATHER = false>
__device__ __forceinline__ void gemm_phase(PG8_LAS unsigned char* lds, const Gemm g, const Sched& S, const Epi& E, const PG8_LAS unsigned* tab) {
    const int tid = opaque_tid(), wid = __builtin_amdgcn_readfirstlane(tid >> 6), lane = tid & 63, wr = wid >> 2, wc = wid & 3, fr = lane & 15, fq = lane >> 4;
    const int Kb = g.Kb, nt = Kb / (BK * 2);
    unsigned voffA[2], voffB[2];
#pragma unroll
    for (int i = 0; i < 2; ++i) { int R, C; stage_rc(tid * 16 + i * 8192, R, C); const int Rb = Epi::PERM ? ((R & ~31) + perm32(R & 31)) : R;
        voffA[i] = (unsigned)(R * g.pa + C * 2); voffB[i] = (unsigned)(Rb * g.pb + C * 2); }
    unsigned vA[2][2] = {{0u, 0u}, {0u, 0u}}, vN[2][2] = {{0u, 0u}, {0u, 0u}}; int gR[2] = {0, 0}; unsigned gC[2] = {0u, 0u};
    if constexpr (GATHER) {
#pragma unroll
        for (int i = 0; i < 2; ++i) { int R, C; stage_rc(tid * 16 + i * 8192, R, C); gR[i] = R; gC[i] = (unsigned)(C * 2); }
#pragma unroll
        for (int h = 0; h < 2; ++h)
#pragma unroll
            for (int i = 0; i < 2; ++i) vA[h][i] = tab[256 + gR[i] + HALF * h] * (unsigned)g.pa + gC[i]; }
    const size_t kstepA = (size_t)g.ka, kstepB = (size_t)g.kb;
    const size_t hstepA = (size_t)HALF * g.pa, hstepB = (size_t)HALF * g.pb;
    const size_t tstepA = g.ta, tstepB = g.tb;
    const unsigned ldsw = (unsigned)wid * 1024u;
    const int aoff = lds_byte(wr * 64 + fr, fq * 8), boff = lds_byte(wc * 32 + fr, fq * 8);
#define PG8_SA(b, h) (((b) * 2 + (h)) * HTB)
#define PG8_SB(b, h) ((4 + (b) * 2 + (h)) * HTB)
#define PG8_STAGE(bufoff, gbase, voff) do { _Pragma("unroll") for (int _i = 0; _i < 2; ++_i) \
        __builtin_amdgcn_global_load_lds((const unsigned*)((const char*)(gbase) + (voff)[_i]), (PG8_LAS unsigned*)(lds + (bufoff) + ldsw + _i * 8192), 16, 0, 0); } while (0)
#define PG8_STAGE_A(bufoff, kptr, h, nx) do { if constexpr (GATHER) { _Pragma("unroll") for (int _i = 0; _i < 2; ++_i) \
        __builtin_amdgcn_global_load_lds((const unsigned*)((const char*)(kptr) + ((nx) ? vN[h][_i] : vA[h][_i])), (PG8_LAS unsigned*)(lds + (bufoff) + ldsw + _i * 8192), 16, 0, 0); } \
        else PG8_STAGE(bufoff, (kptr) + ((h) ? hstepA : (size_t)0), voffA); } while (0)
#define PG8_LD8(p) __builtin_shufflevector(*(const PG8_LAS v4i_t*)(p), *(const PG8_LAS v4i_t*)((p) + 1024), 0, 1, 2, 3, 4, 5, 6, 7)
#define PG8_LDA(dst, b, h) do { _Pragma("unroll") for (int m = 0; m < 4; ++m) dst[m] = PG8_LD8(lds + PG8_SA(b, h) + aoff + m * 2048); } while (0)
#define PG8_LDB(dst, b, h) do { _Pragma("unroll") for (int n = 0; n < 2; ++n) dst[n] = PG8_LD8(lds + PG8_SB(b, h) + boff + n * 2048); } while (0)
#define PG8_LO(v) __builtin_bit_cast(bf16x8, __builtin_shufflevector(v, v, 0, 1, 2, 3))
#define PG8_HI(v) __builtin_bit_cast(bf16x8, __builtin_shufflevector(v, v, 4, 5, 6, 7))
#define PG8_LO4(v) __builtin_shufflevector(v, v, 0, 1, 2, 3)
#define PG8_HI4(v) __builtin_shufflevector(v, v, 4, 5, 6, 7)
#define PG8_MMA(ai, bj, At, Bt) do { __builtin_amdgcn_s_setprio(1); _Pragma("unroll") for (int m = 0; m < 4; ++m) _Pragma("unroll") for (int n = 0; n < 2; ++n) { \
        if constexpr (MODE == 1) { asm volatile("v_mfma_scale_f32_16x16x128_f8f6f4 %0, %1, %2, %0, %3, %3 op_sel_hi:[0,0,0]" : "+v"(acc[ai][bj][m][n]) : "v"(Bt[n]), "v"(At[m]), "v"(sc127)); } \
        else if constexpr (MODE == 2) { v4i_t c_ = __builtin_bit_cast(v4i_t, acc[ai][bj][m][n]); c_ = __builtin_amdgcn_mfma_i32_16x16x64_i8(PG8_LO4(Bt[n]), PG8_LO4(At[m]), c_, 0, 0, 0); \
               c_ = __builtin_amdgcn_mfma_i32_16x16x64_i8(PG8_HI4(Bt[n]), PG8_HI4(At[m]), c_, 0, 0, 0); acc[ai][bj][m][n] = __builtin_bit_cast(f32x4, c_); } \
        else { acc[ai][bj][m][n] = __builtin_amdgcn_mfma_f32_16x16x32_bf16(PG8_LO(Bt[n]), PG8_LO(At[m]), acc[ai][bj][m][n], 0, 0, 0); \
               acc[ai][bj][m][n] = __builtin_amdgcn_mfma_f32_16x16x32_bf16(PG8_HI(Bt[n]), PG8_HI(At[m]), acc[ai][bj][m][n], 0, 0, 0); } } \
        __builtin_amdgcn_s_setprio(0); } while (0)
#define PG8_WAIT_V(n) asm volatile("s_waitcnt vmcnt(" #n ")" ::: "memory")
#define PG8_WAIT_L(n) asm volatile("s_waitcnt lgkmcnt(" #n ")" ::: "memory")
#define PG8_BAR __builtin_amdgcn_s_barrier()
#define PG8_SCHED __builtin_amdgcn_sched_barrier(0)
    Unit cur, nxt; int ui = 0;
    if (!S.next(0, cur)) return;
    int sc127 = 127; asm volatile("" : "+v"(sc127));
    f32x4 acc[2][2][4][2];
#pragma unroll
    for (int a = 0; a < 2; ++a)
#pragma unroll
        for (int b = 0; b < 2; ++b)
#pragma unroll
            for (int m = 0; m < 4; ++m)
#pragma unroll
                for (int n = 0; n < 2; ++n) acc[a][b][m][n] = (f32x4){0.f, 0.f, 0.f, 0.f};
    v8i_t At[4], B0[2], B1[2];
    const char* cA = (const char*)g.A + (GATHER ? (size_t)0 : (size_t)cur.pm * tstepA); const char* cB = (const char*)g.Bt + (size_t)cur.pb * tstepB;
    PG8_STAGE(PG8_SB(0, 0), cB, voffB); PG8_STAGE(PG8_SB(0, 1), cB + hstepB, voffB); PG8_STAGE_A(PG8_SA(0, 0), cA, 0, false); PG8_STAGE_A(PG8_SA(0, 1), cA, 1, false);
    if (wr == 1) PG8_BAR;
    PG8_WAIT_V(2); PG8_BAR;
    PG8_STAGE(PG8_SB(1, 0), cB + kstepB, voffB); PG8_STAGE_A(PG8_SA(1, 0), cA + kstepA, 0, false); PG8_STAGE(PG8_SB(1, 1), cB + hstepB + kstepB, voffB);
    PG8_WAIT_V(6); PG8_BAR;
    for (;;) {
        const bool has_next = S.next(ui + 1, nxt);
        const char* nA = (has_next && !GATHER) ? (const char*)g.A + (size_t)nxt.pm * tstepA : cA; const char* nB = has_next ? (const char*)g.Bt + (size_t)nxt.pb * tstepB : cB;
        if constexpr (GATHER) { const int ub = (has_next ? (ui + 1) : ui) * 512 + 256;
#pragma unroll
            for (int h = 0; h < 2; ++h)
#pragma unroll
                for (int i = 0; i < 2; ++i) vN[h][i] = tab[ub + gR[i] + HALF * h] * (unsigned)g.pa + gC[i]; }
        for (int t = 0; t < nt; t += 2) {
            const bool last = (t == nt - 2);
            const char* a1 = cA + (size_t)(t + 1) * kstepA;
            const char* a2 = last ? nA : cA + (size_t)(t + 2) * kstepA; const char* b2 = last ? nB : cB + (size_t)(t + 2) * kstepB;
            const char* a3 = a2 + kstepA; const char* b3 = b2 + kstepB;
            PG8_LDB(B0, 0, 0); PG8_LDB(B1, 0, 1); PG8_SCHED; PG8_LDA(At, 0, 0); PG8_STAGE_A(PG8_SA(1, 1), a1, 1, false);
            PG8_WAIT_V(8); PG8_WAIT_L(0); PG8_BAR; PG8_MMA(0, 0, At, B0); PG8_MMA(0, 1, At, B1); PG8_BAR; PG8_SCHED;
            PG8_LDA(At, 0, 1); PG8_STAGE(PG8_SB(0, 0), b2, voffB); PG8_STAGE(PG8_SB(0, 1), b2 + hstepB, voffB); PG8_STAGE_A(PG8_SA(0, 0), a2, 0, last);
            PG8_WAIT_V(8); PG8_WAIT_L(0); PG8_BAR; PG8_MMA(1, 0, At, B0); PG8_MMA(1, 1, At, B1); PG8_BAR; PG8_SCHED;
            PG8_LDB(B0, 1, 0); PG8_LDB(B1, 1, 1); PG8_SCHED; PG8_LDA(At, 1, 0); PG8_STAGE_A(PG8_SA(0, 1), a2, 1, last);
            PG8_WAIT_V(8); PG8_WAIT_L(0); PG8_BAR; PG8_MMA(0, 0, At, B0); PG8_MMA(0, 1, At, B1); PG8_BAR; PG8_SCHED;
            PG8_LDA(At, 1, 1); PG8_STAGE(PG8_SB(1, 0), b3, voffB); PG8_STAGE(PG8_SB(1, 1), b3 + hstepB, voffB); PG8_STAGE_A(PG8_SA(1, 0), a3, 0, last);
            PG8_WAIT_V(8); PG8_WAIT_L(0); PG8_BAR; PG8_MMA(1, 0, At, B0); PG8_MMA(1, 1, At, B1); PG8_BAR; PG8_SCHED;
        }
        if (wr == 0) PG8_BAR;
        if constexpr (MODE == 1) asm volatile("s_nop 15\n\ts_nop 15" ::: "memory");
        E(acc, cur, wr, wc, fr, fq, tab + ui * 512);
        if constexpr (MODE == 1) asm volatile("s_nop 7" ::: "memory");
        if (!has_next) break;
#pragma unroll
        for (int a = 0; a < 2; ++a)
#pragma unroll
            for (int b = 0; b < 2; ++b)
#pragma unroll
                for (int m = 0; m < 4; ++m)
#pragma unroll
                    for (int n = 0; n < 2; ++n) acc[a][b][m][n] = (f32x4){0.f, 0.f, 0.f, 0.f};
        cur = nxt; cA = nA; cB = nB; ++ui;
        if constexpr (GATHER) { vA[0][0] = vN[0][0]; vA[0][1] = vN[0][1]; vA[1][0] = vN[1][0]; vA[1][1] = vN[1][1]; }
        if (wr == 1) PG8_BAR;
    }
    PG8_WAIT_V(0);
    PG8_BAR;
#undef PG8_SA
#undef PG8_SB
#undef PG8_STAGE
#undef PG8_STAGE_A
#undef PG8_LDA
#undef PG8_LDB
#undef PG8_LD8
#undef PG8_LO
#undef PG8_HI
#undef PG8_LO4
#undef PG8_HI4
#undef PG8_MMA
#undef PG8_WAIT_V
#undef PG8_WAIT_L
#undef PG8_BAR
#undef PG8_SCHED
}
}

constexpr int NWAVES = 8, NTHREADS = NWAVES * 64;
constexpr size_t MiB = 1u << 20;
constexpr size_t WS_CTL = 0, CTL_ZERO_BYTES = 1 * MiB;
constexpr size_t WS_COS = 1 * MiB, WS_SIN = 2 * MiB;
constexpr size_t WS_ASSQ = 3 * MiB;
constexpr size_t WS_TOKE = 4 * MiB, WS_TOKW = 5 * MiB, WS_TOKR = 6 * MiB;
constexpr size_t WS_CNT = 7 * MiB;
constexpr size_t WS_SDST = 8 * MiB, WS_SW = 9 * MiB, WS_SRS = 10 * MiB;
constexpr size_t WS_TILEE = 11 * MiB;
constexpr size_t WS_WR = 12 * MiB;
constexpr size_t WS_DECT = 14 * MiB;
constexpr size_t WS_DS = 16 * MiB;
constexpr size_t WS_WIN = 64 * MiB, WS_WOUT = 84 * MiB, WS_WGU = 92 * MiB, WS_WD = 348 * MiB;
constexpr size_t WS_XN = 476 * MiB;
constexpr size_t WS_PROJ = 540 * MiB;
constexpr size_t WS_ARAW = 692 * MiB;
constexpr size_t WS_MIX = 724 * MiB;
constexpr int XN2_P = 2176;
constexpr size_t WS_XN2 = 756 * MiB;
constexpr size_t WS_HID = 820 * MiB;
constexpr size_t WS_SIN_ST = 900 * MiB;
constexpr size_t WS_OF = 932 * MiB;
constexpr size_t WS_H = 476 * MiB;
constexpr size_t WS_XS = 540 * MiB;
constexpr size_t WS_Y = 640 * MiB;
constexpr size_t WS_END = 996 * MiB;
constexpr int CW_CMAX_IN = 16384, CW_CMAX_OUT = 16384 + 4864;
constexpr size_t WS_SAX = 15 * MiB, WS_SAM = 15 * MiB + 65536;
constexpr int CW_BAR = 4096;
constexpr int RING_BYTES = 131072, LDSCTL_OFF = RING_BYTES, MISC_OFF = LDSCTL_OFF + 320, TILEE_OFF = MISC_OFF + 128;
constexpr int LDS_BYTES = 147456;
constexpr int UTAB_UNITS = 6;
static_assert(TILEE_OFF + 2048 + UTAB_UNITS * 2048 <= LDS_BYTES, "unit tables do not fit");

#define GAS __attribute__((address_space(1)))
#define LAS __attribute__((address_space(3)))
typedef unsigned short bf16;
typedef float f32x4 __attribute__((ext_vector_type(4)));
typedef float f32x16 __attribute__((ext_vector_type(16)));
typedef short bf16x8 __attribute__((ext_vector_type(8)));
typedef short s16x4 __attribute__((ext_vector_type(4)));
typedef unsigned u32x4 __attribute__((ext_vector_type(4)));
typedef unsigned u32x2 __attribute__((ext_vector_type(2)));
#define LDS_WAIT() asm volatile("s_waitcnt lgkmcnt(0)" ::: "memory")
#define VM_WAIT() asm volatile("s_waitcnt vmcnt(0)" ::: "memory")
#define SBAR() __builtin_amdgcn_sched_barrier(0)
__device__ __forceinline__ unsigned f2bf(float f) { unsigned u = __builtin_bit_cast(unsigned, f); return (u + 0x7fffu + ((u >> 16) & 1u)) >> 16; }
__device__ __forceinline__ unsigned pk2(float lo, float hi) { return f2bf(lo) | (f2bf(hi) << 16); }
__device__ __forceinline__ float bflo(unsigned w) { return __builtin_bit_cast(float, w << 16); }
__device__ __forceinline__ float bfhi(unsigned w) { return __builtin_bit_cast(float, w & 0xffff0000u); }
#define WV_DPP(v, ctrl, rmask) __builtin_bit_cast(float, __builtin_amdgcn_update_dpp(0, __builtin_bit_cast(int, v), ctrl, rmask, 0xF, false))
__device__ __forceinline__ float wave_max(float v) {
    v = fmaxf(v, WV_DPP(v, 0x111, 0xF)); v = fmaxf(v, WV_DPP(v, 0x112, 0xF)); v = fmaxf(v, WV_DPP(v, 0x114, 0xF)); v = fmaxf(v, WV_DPP(v, 0x118, 0xF));
    v = fmaxf(v, WV_DPP(v, 0x142, 0xA)); v = fmaxf(v, WV_DPP(v, 0x143, 0xC));
    return __builtin_bit_cast(float, __builtin_amdgcn_readlane(__builtin_bit_cast(int, v), 63));
}
__device__ __forceinline__ float wave_sum(float v) {
    v += WV_DPP(v, 0x111, 0xF); v += WV_DPP(v, 0x112, 0xF); v += WV_DPP(v, 0x114, 0xF); v += WV_DPP(v, 0x118, 0xF);
    v += WV_DPP(v, 0x142, 0xA); v += WV_DPP(v, 0x143, 0xC);
    return __builtin_bit_cast(float, __builtin_amdgcn_readlane(__builtin_bit_cast(int, v), 63));
}

#define XB_TMO      128
#define XB_XCNT(j)  (256  + 64 * (j))
#define XB_XSUB(j)  (1280 + 64 * (j))
#define XB_XGEN(j)  (2304 + 64 * (j))
#define XB_TOP      3328
#define XB_TOPGEN   3392
#define XCD_BAR_WORDS 3456
#define XB_SPIN_CAP (1u << 18)
__device__ __forceinline__ unsigned xb_ld(unsigned* p)              { return __hip_atomic_load(p, __ATOMIC_RELAXED, __HIP_MEMORY_SCOPE_AGENT); }
__device__ __forceinline__ unsigned xb_add(unsigned* p, unsigned v) { return __hip_atomic_fetch_add(p, v, __ATOMIC_RELAXED, __HIP_MEMORY_SCOPE_AGENT); }
__device__ __forceinline__ unsigned xb_xcc_id() { return (unsigned)__builtin_amdgcn_s_getreg((3 << 11) | 20) & 0xFu; }
#define XB_SPIN(cond, bar) do { unsigned _sp = 0; while (cond) { __builtin_amdgcn_s_sleep(1); \
    if ((++_sp & 255u) == 0u) { if (xb_ld(&(bar)[XB_TMO])) break; if (_sp > XB_SPIN_CAP) { atomicAdd(&(bar)[XB_TMO], 1u); break; } } } } while (0)
struct XcdBarrier { unsigned* bar; unsigned x; volatile LAS unsigned* st; };
__device__ __forceinline__ XcdBarrier xcd_barrier_post(unsigned* bar, volatile LAS unsigned* st) {
    XcdBarrier b; b.bar = bar; b.x = xb_xcc_id(); b.st = st;
    if (threadIdx.x == 0) (void)xb_add(&bar[XB_XCNT(b.x)], 1u);
    return b;
}
__device__ __forceinline__ void xcd_barrier_complete(unsigned* bar, unsigned x, unsigned& nloc, unsigned& nx) {
    const unsigned G = gridDim.x * gridDim.y * gridDim.z;
    unsigned sum, cnt, mine, sp = 0u;
    for (;;) {
        sum = 0u; cnt = 0u; mine = 0u;
#pragma unroll
        for (unsigned j = 0; j < 16; ++j) { const unsigned c = xb_ld(&bar[XB_XCNT(j)]); sum += c; cnt += (c > 0u) ? 1u : 0u; mine = (j == x) ? c : mine; }
        if (sum == G) break;
        __builtin_amdgcn_s_sleep(1);
        if ((++sp & 255u) == 0u) { if (xb_ld(&bar[XB_TMO])) break; if (sp > XB_SPIN_CAP) { atomicAdd(&bar[XB_TMO], 1u); break; } }
    }
    nloc = mine > 0u ? mine : 1u; nx = cnt > 0u ? cnt : 1u;
}
__device__ __forceinline__ void xcd_barrier(const XcdBarrier& b) {
    asm volatile("s_waitcnt vmcnt(0)" ::: "memory");
    __syncthreads();
    if (threadIdx.x == 0) {
        unsigned* bar = b.bar;
        __builtin_amdgcn_s_waitcnt(0);
        unsigned nloc = b.st[0], nx = b.st[1];
        if (nloc == 0u) { xcd_barrier_complete(bar, b.x, nloc, nx); b.st[0] = nloc; b.st[1] = nx; }
        const unsigned old = xb_add(&bar[XB_XSUB(b.x)], 1u);
        const unsigned gen = old / nloc;
        if (old + 1u == (gen + 1u) * nloc) {
            __builtin_amdgcn_fence(__ATOMIC_RELEASE, "agent");
            asm volatile("s_waitcnt vmcnt(0)" ::: "memory");
            const unsigned og = xb_add(&bar[XB_TOP], 1u);
            const unsigned tg = og / nx;
            if (og + 1u == (tg + 1u) * nx) xb_add(&bar[XB_TOPGEN], 1u);
            else XB_SPIN(xb_ld(&bar[XB_TOPGEN]) == tg, bar);
            __builtin_amdgcn_fence(__ATOMIC_ACQUIRE, "agent");
            xb_add(&bar[XB_XGEN(b.x)], 1u);
            asm volatile("s_waitcnt vmcnt(0)" ::: "memory");
        } else {
            XB_SPIN(xb_ld(&bar[XB_XGEN(b.x)]) == gen, bar);
            __builtin_amdgcn_fence(__ATOMIC_ACQUIRE, "agent");
            asm volatile("s_waitcnt vmcnt(0)" ::: "memory");
        }
    }
    __syncthreads();
}

struct Args { const float* in[21]; float* out; unsigned char* ws; };
enum { I_X = 0, I_LN1, I_WIN, I_QNW, I_KNW, I_SINK, I_ANW, I_UPF, I_BF, I_UPB, I_BB, I_GNW, I_WOUT, I_LN2, I_WG, I_BG, I_WR, I_BR, I_WGE, I_WUE, I_WDE };

__device__ __forceinline__ unsigned pk4_i8(float a, float b, float c, float d) { const int i0 = __float2int_rn(a), i1 = __float2int_rn(b), i2 = __float2int_rn(c), i3 = __float2int_rn(d); return (unsigned)(i0 & 0xff) | ((unsigned)(i1 & 0xff) << 8) | ((unsigned)(i2 & 0xff) << 16) | ((unsigned)i3 << 24); }
struct TItem { const float* W; unsigned char* WT; const float* colmax; size_t dst_row0; int ldn, k0, n0, ldkb; float scale; };
__device__ __forceinline__ void titem_load(const TItem& t, f32x4 (&v)[16], int lane) {
    const int kr = lane >> 3, n4 = (lane & 7) * 4;
#pragma unroll
    for (int i = 0; i < 16; ++i) v[i] = __builtin_nontemporal_load((const GAS f32x4*)(t.W + (size_t)(t.k0 + 8 * i + kr) * t.ldn + t.n0 + n4));
}
__device__ __forceinline__ void titem_store_i8(const TItem& t, const f32x4 (&v)[16], LAS float* scr, int lane, const float (&scale_n)[4]) {
    const int kr = lane >> 3, q = lane & 7, nj = lane >> 3, p = lane & 7;
#pragma unroll
    for (int i = 0; i < 16; ++i) *(LAS f32x4*)(scr + (8 * i + kr) * 32 + 4 * (q ^ (i >> 1))) = v[i];
    LDS_WAIT(); asm volatile("" ::: "memory");
#pragma unroll
    for (int itr = 0; itr < 4; ++itr) { const int n = 8 * itr + nj; const LAS float* s = scr + (2 * p) * 256 + 4 * ((n >> 2) ^ p) + (n & 3); float f[16]; const float scale = scale_n[itr];
#pragma unroll
        for (int i = 0; i < 16; ++i) f[i] = s[(i >> 3) * 256 + (i & 7) * 32] * scale;
        u32x4 o; o.x = pk4_i8(f[0], f[1], f[2], f[3]); o.y = pk4_i8(f[4], f[5], f[6], f[7]); o.z = pk4_i8(f[8], f[9], f[10], f[11]); o.w = pk4_i8(f[12], f[13], f[14], f[15]);
        const size_t dr = t.dst_row0 + n;
        *(GAS u32x4*)(t.WT + dr * (size_t)t.ldkb + t.k0 + 16 * p) = o; }
    LDS_WAIT(); asm volatile("" ::: "memory");
}
template <int CLS> __device__ __forceinline__ TItem titem_make(const Args& a, int r) {
    unsigned char* ws = a.ws; TItem t; t.colmax = nullptr; t.scale = pg8::WSCALE;
    if (CLS == 0) { const int up = r >= 32 * 512; if (up) r -= 32 * 512; const int e = r >> 9, rr = r & 511, kb = rr >> 5, nb = rr & 31, n0 = nb * 32;
        t.W = a.in[up ? I_WUE : I_WGE] + (size_t)e * DM * DFF; t.ldn = DFF; t.k0 = kb * 128; t.n0 = n0; t.WT = ws + WS_WGU + (size_t)e * 2048 * DM; t.dst_row0 = (size_t)((n0 >> 7) * 256 + (n0 & 127) + up * 128); t.ldkb = -DM; }
    else if (CLS == 1) { const int e = r >> 9, rr = r & 511, kb = rr >> 6, nb = rr & 63;
        t.W = a.in[I_WDE] + (size_t)e * DFF * DM; t.ldn = DM; t.k0 = kb * 128; t.n0 = nb * 32; t.WT = ws + WS_WD + (size_t)e * DM * DFF; t.dst_row0 = (size_t)nb * 32; t.ldkb = -DFF; }
    else { t.scale = 1.f;
        if (r < 16 * 145) { const int kb = r / 145, nb = r % 145; t.W = a.in[I_WIN]; t.ldn = IN_W; t.k0 = kb * 128; t.n0 = nb * 32; t.WT = ws + WS_WIN; t.dst_row0 = (size_t)nb * 32; t.ldkb = DM; t.colmax = (const float*)(ws + WS_CTL) + CW_CMAX_IN; }
        else { r -= 16 * 145; const int kb = r >> 6, nb = r & 63; t.W = a.in[I_WOUT]; t.ldn = DM; t.k0 = kb * 128; t.n0 = nb * 32; t.WT = ws + WS_WOUT; t.dst_row0 = (size_t)nb * 32; t.ldkb = DM; t.colmax = (const float*)(ws + WS_CTL) + CW_CMAX_OUT; } }
    return t;
}
template <int CLS> __device__ __forceinline__ void titem_run(const Args& a, int it0, int nitems, int gw, int NGW, LAS float* scr, int lane) {
    static_assert(CLS != 2, "the int8 items go through p0_strip");
    const int kr = lane >> 3, q = lane & 7, nj = lane >> 3, p = lane & 7;
#pragma unroll 1
    for (int it = gw; it < nitems; it += NGW) { const TItem t = titem_make<CLS>(a, it0 + it);
        const float* src = t.W + (size_t)(t.k0 + kr) * t.ldn + t.n0;
#pragma unroll
        for (int i = 0; i < 16; ++i) __builtin_amdgcn_global_load_lds((const unsigned*)(src + (size_t)(8 * i) * t.ldn + 4 * (q ^ (i >> 1))), (LAS unsigned*)(scr + (8 * i) * 32), 16, 0, 2);
        asm volatile("s_waitcnt vmcnt(0)" ::: "memory");
        const float scale = t.scale;
#pragma unroll
        for (int itr = 0; itr < 4; ++itr) { const int n = 8 * itr + nj; const LAS float* s = scr + (2 * p) * 256 + 4 * ((n >> 2) ^ p) + (n & 3); float f[16];
#pragma unroll
            for (int i = 0; i < 16; ++i) f[i] = s[(i >> 3) * 256 + (i & 7) * 32] * scale;
            u32x4 o; o.x = pg8::pk4_fp8(f[0], f[1], f[2], f[3]); o.y = pg8::pk4_fp8(f[4], f[5], f[6], f[7]); o.z = pg8::pk4_fp8(f[8], f[9], f[10], f[11]); o.w = pg8::pk4_fp8(f[12], f[13], f[14], f[15]);
            size_t dr = t.dst_row0 + n;
            if (CLS == 1) { const int cl0 = (int)(t.dst_row0 & 255) + 8 * itr; dr = (t.dst_row0 & ~(size_t)255) + 128 * ((cl0 >> 3) & 1) + 32 * (cl0 >> 6) + 8 * ((cl0 >> 4) & 3) + nj; }
            unsigned char* dp = t.ldkb > 0 ? t.WT + dr * (size_t)t.ldkb + t.k0 + 16 * p : t.WT + (dr >> 8) * (size_t)(256 * -t.ldkb) + (size_t)(t.k0 >> 7) * 32768 + (dr & 255) * 128 + 16 * p;
            __builtin_nontemporal_store(o, (GAS u32x4*)dp); }
        LDS_WAIT(); asm volatile("" ::: "memory"); }
}
__device__ __forceinline__ void p0_strip(const Args& a, int strip, LAS float* scr, LAS float* cmw, int wave, int lane) {
    unsigned char* ws = a.ws; const bool o = strip >= 145; const int nb = o ? strip - 145 : strip, ldn = o ? DM : IN_W, n0 = nb * 32;
    const float* W = a.in[o ? I_WOUT : I_WIN]; float* cm = (float*)(ws + WS_CTL) + (o ? CW_CMAX_OUT : CW_CMAX_IN);
    const int n4 = (lane & 7) * 4;
    TItem t0; t0.W = W; t0.ldn = ldn; t0.n0 = n0; t0.WT = ws + (o ? WS_WOUT : WS_WIN); t0.dst_row0 = (size_t)n0; t0.ldkb = DM; t0.colmax = nullptr; t0.scale = 1.f; t0.k0 = (2 * wave) * 128;
    TItem t1 = t0; t1.k0 = (2 * wave + 1) * 128;
    f32x4 v0[16], v1[16]; titem_load(t0, v0, lane); titem_load(t1, v1, lane);
    f32x4 m = {0.f, 0.f, 0.f, 0.f};
#pragma unroll
    for (int i = 0; i < 16; ++i) { m.x = fmaxf(m.x, fmaxf(fabsf(v0[i].x), fabsf(v1[i].x))); m.y = fmaxf(m.y, fmaxf(fabsf(v0[i].y), fabsf(v1[i].y))); m.z = fmaxf(m.z, fmaxf(fabsf(v0[i].z), fabsf(v1[i].z))); m.w = fmaxf(m.w, fmaxf(fabsf(v0[i].w), fabsf(v1[i].w))); }
#pragma unroll
    for (int s = 8; s < 64; s <<= 1) { m.x = fmaxf(m.x, __shfl_xor(m.x, s)); m.y = fmaxf(m.y, __shfl_xor(m.y, s)); m.z = fmaxf(m.z, __shfl_xor(m.z, s)); m.w = fmaxf(m.w, __shfl_xor(m.w, s)); }
    if (lane < 8) *(LAS f32x4*)(cmw + wave * 32 + n4) = m;
    __syncthreads();
    float cmn = 0.f;
#pragma unroll
    for (int w = 0; w < 8; ++w) cmn = fmaxf(cmn, cmw[w * 32 + (lane & 31)]);
    if (wave == 0 && lane < 32) cm[n0 + lane] = cmn;
    float scale_n[4];
#pragma unroll
    for (int itr = 0; itr < 4; ++itr) { const float c = __shfl(cmn, 8 * itr + (lane >> 3)); scale_n[itr] = c > 0.f ? 127.f / c : 0.f; }
    titem_store_i8(t0, v0, scr, lane, scale_n);
    titem_store_i8(t1, v1, scr, lane, scale_n);
    __syncthreads();
}
__device__ __forceinline__ void p0_prologue(const Args& a, LAS unsigned char* lds, int wave, int lane, int G) {
    unsigned char* ws = a.ws;
    LAS float* scr = (LAS float*)(lds + wave * 16384);
    const int gw = blockIdx.x * NWAVES + wave, NGW = G * NWAVES;
    const int gt = blockIdx.x * NTHREADS + threadIdx.x, NGT = G * NTHREADS;
    constexpr int NSTRIP_IN = 145;
    { LAS float* cmw = (LAS float*)(lds + TILEE_OFF + 1024);
      for (int s = blockIdx.x; s < NSTRIP_IN; s += G) p0_strip(a, s, scr, cmw, wave, lane); }
    { GAS u32x4* z = (GAS u32x4*)(ws + WS_WIN + (size_t)IN_W * DM); const int n16 = (PROJ_LD - IN_W) * DM / 16;
      for (int i = gt; i < n16; i += NGT) z[i] = (u32x4){0u, 0u, 0u, 0u}; }
    { bf16* wr = (bf16*)(ws + WS_WR);
      for (int i = gt; i < 64 * DM; i += NGT) { const int n = i >> 11, k = i & 2047; float v = 0.f;
          if (n < 4) v = a.in[I_WG][k * 4 + n]; else if (n < 36) v = a.in[I_WR][k * 32 + (n - 4)];
          wr[i] = (bf16)f2bf(v); } }
    { float* cs = (float*)(ws + WS_COS); float* sn = (float*)(ws + WS_SIN);
      for (int i = gt; i < S_ * 16; i += NGT) { const int pos = i >> 4, f = i & 15; double inv;
          switch (f) { case 0: inv = 1.0; break; case 1: inv = 0.4403666026717805; break; case 2: inv = 0.1939227447486858; break; case 3: inv = 0.08539710028576561; break;
              case 4: inv = 0.03760603093086394; break; case 5: inv = 0.016560440080994443; break; case 6: inv = 0.007292664737217109; break; case 7: inv = 0.0032114459947525913; break;
              case 8: inv = 0.0014142135623730955; break; case 9: inv = 0.0006227724219145962; break; case 10: inv = 0.00027424817567620724; break; case 11: inv = 0.00012076973741146502; break;
              case 12: inv = 5.318295896944988e-05; break; case 13: inv = 2.3419998961409345e-05; break; case 14: inv = 1.0313385377212461e-05; break; default: inv = 4.541670480607871e-06; break; }
          const double rev = (double)pos * inv * 0.15915494309189535; const float fr = (float)(rev - rint(rev)) * 6.283185307179586f;
          cs[i] = cosf(fr); sn[i] = sinf(fr); } }
    { const float* x = a.in[I_X]; const float* lw = a.in[I_LN1]; unsigned char* xn = ws + WS_XN; float* sax = (float*)(ws + WS_SAX);
      f32x4 w[8];
#pragma unroll
      for (int j = 0; j < 8; ++j) w[j] = *((const f32x4*)lw + lane + 64 * j);
      f32x4 v[8];
      const bool wgt = (G == 256); const int bx = blockIdx.x;
      const int NSLOT = wgt ? NWAVES * (NSTRIP_IN + 2 * (256 - NSTRIP_IN)) : NGW;
      const int slot0 = wgt ? (bx < NSTRIP_IN ? bx * NWAVES + wave : NSTRIP_IN * NWAVES + (bx - NSTRIP_IN) * 2 * NWAVES + wave) : gw;
      const int nsl = (wgt && bx >= NSTRIP_IN) ? 2 : 1;
      for (int sl = 0; sl < nsl; ++sl) {
      const int rw = slot0 + sl * NWAVES, RNW = NSLOT;
      if (rw >= 0 && rw < S_) { const GAS f32x4* xr = (const GAS f32x4*)(x + (size_t)rw * DM) + lane;
#pragma unroll
          for (int j = 0; j < 8; ++j) v[j] = __builtin_nontemporal_load(xr + 64 * j); }
#pragma unroll 1
      for (int m = rw; m >= 0 && m < S_; m += RNW) { const int mn = (m + RNW < S_) ? m + RNW : m; const GAS f32x4* xr = (const GAS f32x4*)(x + (size_t)mn * DM) + lane;
          f32x4 vn[8]; float s = 0.f;
#pragma unroll
          for (int j = 0; j < 8; ++j) vn[j] = __builtin_nontemporal_load(xr + 64 * j);
#pragma unroll
          for (int j = 0; j < 8; ++j) s += (v[j].x * v[j].x + v[j].y * v[j].y) + (v[j].z * v[j].z + v[j].w * v[j].w);
          const float rstd = 1.f / sqrtf(wave_sum(s) * (1.f / DM) + EPS_); float mx = 0.f;
#pragma unroll
          for (int j = 0; j < 8; ++j) { v[j] = v[j] * rstd * w[j]; mx = fmaxf(fmaxf(mx, fmaxf(fabsf(v[j].x), fabsf(v[j].y))), fmaxf(fabsf(v[j].z), fabsf(v[j].w))); }
          mx = wave_max(mx); const float inv = mx > 0.f ? 127.f / mx : 0.f;
          if (lane == 0) sax[m] = mx * (1.f / 127.f);
          GAS unsigned* o4 = (GAS unsigned*)(xn + (size_t)m * DM) + lane;
#pragma unroll
          for (int j = 0; j < 8; ++j) o4[64 * j] = pk4_i8(v[j].x * inv, v[j].y * inv, v[j].z * inv, v[j].w * inv);
#pragma unroll
          for (int j = 0; j < 8; ++j) v[j] = vn[j]; } } }
}

__device__ __forceinline__ void qk_norm_rope(const Args& a, int wave, int lane, int G) {
    bf16* proj = (bf16*)(a.ws + WS_PROJ); const float* cs = (const float*)(a.ws + WS_COS); const float* sn = (const float*)(a.ws + WS_SIN);
    const int gw = blockIdx.x * NWAVES + wave, NGW = G * NWAVES; const int l16 = lane & 15, sub = lane >> 4;
    float wq[8], wk[8];
#pragma unroll
    for (int e = 0; e < 8; ++e) { wq[e] = a.in[I_QNW][8 * l16 + e]; wk[e] = a.in[I_KNW][8 * l16 + e]; }
    for (int rs = gw * 4 + sub; rs < S_ * 2; rs += NGW * 4) {
        const int t = rs >> 1, j = 8 + (rs & 1); const int col0 = C_AK + (j - 8) * 128 + 8 * l16;
        GAS u32x4* p = (GAS u32x4*)(proj + (size_t)t * PROJ_LD + col0); const u32x4 raw = *p;
        float y[8]; y[0] = bflo(raw.x); y[1] = bfhi(raw.x); y[2] = bflo(raw.y); y[3] = bfhi(raw.y); y[4] = bflo(raw.z); y[5] = bfhi(raw.z); y[6] = bflo(raw.w); y[7] = bfhi(raw.w);
        float s = 0.f;
#pragma unroll
        for (int e = 0; e < 8; ++e) s += y[e] * y[e];
        s += __shfl_xor(s, 1); s += __shfl_xor(s, 2); s += __shfl_xor(s, 4); s += __shfl_xor(s, 8);
        const float rstd = 1.f / sqrtf(s * (1.f / 128.f) + EPS_);
#pragma unroll
        for (int e = 0; e < 8; ++e) y[e] = y[e] * rstd * (j < 8 ? wq[e] : wk[e]);
        float pr[8];
#pragma unroll
        for (int e = 0; e < 8; ++e) pr[e] = __shfl_xor(y[e], 2);
        if (l16 < 4) { const int fi = 8 * (l16 & 1); const float sg = (l16 < 2) ? -1.f : 1.f;
#pragma unroll
            for (int e = 0; e < 8; ++e) { const float c = cs[t * 16 + fi + e], sv = sn[t * 16 + fi + e]; y[e] = y[e] * c + sg * pr[e] * sv; } }
        u32x4 o; o.x = pk2(y[0], y[1]); o.y = pk2(y[2], y[3]); o.z = pk2(y[4], y[5]); o.w = pk2(y[6], y[7]);
        *p = o;
    }
}

#define KSWZ(row, colB) ((row) * 256 + ((colB) ^ (((row) & 7) << 4)))
__device__ __forceinline__ int crow(int r, int hi) { return (r & 3) + 8 * (r >> 2) + 4 * hi; }
__device__ __forceinline__ unsigned cvtpk(float lo, float hi) { unsigned r; asm volatile("v_cvt_pk_bf16_f32 %0, %1, %2" : "=v"(r) : "v"(lo), "v"(hi)); return r; }
__device__ __forceinline__ int v_st(int k, int c) { const int kk = (k & ~0xC) | ((k & 4) << 1) | ((k & 8) >> 1); return ((kk >> 3) * 4 + (c >> 5)) * 512 + ((kk & 7) * 32 + (c & 31)) * 2; }
__device__ __forceinline__ int v_rd_base(int lane) { return ((lane & 3) << 3) | (((lane >> 2) & 3) << 6) | (((lane >> 4) & 1) << 5) | (((lane >> 5) & 1) << 8); }
constexpr int v_rd_off(int d0, int ks, int half) { return d0 * 512 + ks * 4096 + half * 2048; }
template <int OFF> __device__ __forceinline__ s16x4 tr_read(int vb) { s16x4 r; asm volatile("ds_read_b64_tr_b16 %0, %1 offset:%2" : "=&v"(r) : "v"(vb), "i"(OFF) : "memory"); return r; }
template <int D0> __device__ __forceinline__ void pv_one(f32x16& od, int vb, bf16x8 pa0, bf16x8 pa1, bf16x8 pa2, bf16x8 pa3) {
    const s16x4 l0 = tr_read<v_rd_off(D0, 0, 0)>(vb), h0 = tr_read<v_rd_off(D0, 0, 1)>(vb), l1 = tr_read<v_rd_off(D0, 1, 0)>(vb), h1 = tr_read<v_rd_off(D0, 1, 1)>(vb);
    const s16x4 l2 = tr_read<v_rd_off(D0, 2, 0)>(vb), h2 = tr_read<v_rd_off(D0, 2, 1)>(vb), l3 = tr_read<v_rd_off(D0, 3, 0)>(vb), h3 = tr_read<v_rd_off(D0, 3, 1)>(vb);
    asm volatile("s_waitcnt lgkmcnt(0)" ::: "memory"); SBAR();
#define PKV(L, H) (bf16x8){L[0], L[1], L[2], L[3], H[0], H[1], H[2], H[3]}
    od = __builtin_amdgcn_mfma_f32_32x32x16_bf16(pa0, PKV(l0, h0), od, 0, 0, 0);
    od = __builtin_amdgcn_mfma_f32_32x32x16_bf16(pa1, PKV(l1, h1), od, 0, 0, 0);
    od = __builtin_amdgcn_mfma_f32_32x32x16_bf16(pa2, PKV(l2, h2), od, 0, 0, 0);
    od = __builtin_amdgcn_mfma_f32_32x32x16_bf16(pa3, PKV(l3, h3), od, 0, 0, 0);
#undef PKV
}
__device__ __forceinline__ void attn_unit(const Args& a, unsigned char* lds, int tb, int g) {
    constexpr float SCALE = 0.088388347648318440f, C = SCALE * 1.4426950408889634f, NEG = -1e30f;
    const int tid = opaque_tid(), wid = __builtin_amdgcn_readfirstlane(tid >> 6), lane = tid & 63, r32 = lane & 31, hi = lane >> 5;
    const bf16* proj = (const bf16*)(a.ws + WS_PROJ); bf16* araw = (bf16*)(a.ws + WS_ARAW); float* assq = (float*)(a.ws + WS_ASSQ);
    const int t0 = tb * 64, hq = 4 * g + (wid >> 1), qrow = t0 + 32 * (wid & 1) + r32;
    bf16* K_lds = (bf16*)lds; bf16* V_lds = (bf16*)(lds + 16384);
    float* wsf = (float*)(lds + 32768) + wid * 64; float* al_l = wsf; float* li_l = wsf + 32;
    bf16* stg = (bf16*)(lds + 36864) + wid * 4096;
    bf16x8 qr[8];
    { const bf16* Qw = proj + (size_t)qrow * PROJ_LD + C_AQ + hq * 128 + hi * 8;
      u32x4 raw[8];
#pragma unroll
      for (int d0 = 0; d0 < 8; ++d0) raw[d0] = *(const u32x4*)(Qw + d0 * 16);
      float qf[8][8]; float ss = 0.f;
#pragma unroll
      for (int d0 = 0; d0 < 8; ++d0) { qf[d0][0] = bflo(raw[d0].x); qf[d0][1] = bfhi(raw[d0].x); qf[d0][2] = bflo(raw[d0].y); qf[d0][3] = bfhi(raw[d0].y); qf[d0][4] = bflo(raw[d0].z); qf[d0][5] = bfhi(raw[d0].z); qf[d0][6] = bflo(raw[d0].w); qf[d0][7] = bfhi(raw[d0].w);
#pragma unroll
          for (int e = 0; e < 8; ++e) ss += qf[d0][e] * qf[d0][e]; }
      { auto rr = __builtin_amdgcn_permlane32_swap(__float_as_uint(ss), __float_as_uint(ss), false, false); ss = __uint_as_float(rr[0]) + __uint_as_float(rr[1]); }
      const float rstd = 1.f / sqrtf(ss * (1.f / 128.f) + EPS_);
      const float* qnw = a.in[I_QNW] + hi * 8;
#pragma unroll
      for (int d0 = 0; d0 < 8; ++d0) { const f32x4 w0 = *(const f32x4*)(qnw + d0 * 16), w1 = *(const f32x4*)(qnw + d0 * 16 + 4);
          qf[d0][0] *= rstd * w0.x; qf[d0][1] *= rstd * w0.y; qf[d0][2] *= rstd * w0.z; qf[d0][3] *= rstd * w0.w; qf[d0][4] *= rstd * w1.x; qf[d0][5] *= rstd * w1.y; qf[d0][6] *= rstd * w1.z; qf[d0][7] *= rstd * w1.w; }
      { const float* cs = (const float*)(a.ws + WS_COS) + (size_t)qrow * 16 + hi * 8; const float* sn = (const float*)(a.ws + WS_SIN) + (size_t)qrow * 16 + hi * 8;
        const f32x4 c0 = *(const f32x4*)cs, c1 = *(const f32x4*)(cs + 4), s0 = *(const f32x4*)sn, s1 = *(const f32x4*)(sn + 4);
        const float cv[8] = {c0.x, c0.y, c0.z, c0.w, c1.x, c1.y, c1.z, c1.w}, sv[8] = {s0.x, s0.y, s0.z, s0.w, s1.x, s1.y, s1.z, s1.w};
#pragma unroll
        for (int e = 0; e < 8; ++e) { const float y1 = qf[0][e], y2 = qf[1][e]; qf[0][e] = y1 * cv[e] - y2 * sv[e]; qf[1][e] = y2 * cv[e] + y1 * sv[e]; } }
#pragma unroll
      for (int d0 = 0; d0 < 8; ++d0) { u32x4 w; w.x = pk2(qf[d0][0], qf[d0][1]); w.y = pk2(qf[d0][2], qf[d0][3]); w.z = pk2(qf[d0][4], qf[d0][5]); w.w = pk2(qf[d0][6], qf[d0][7]); qr[d0] = __builtin_bit_cast(bf16x8, w); } }
    float m_reg = a.in[I_SINK][hq] * (1.f / SCALE), l_reg = 1.f;
    f32x16 o[4]; o[0] = f32x16{}; o[1] = f32x16{}; o[2] = f32x16{}; o[3] = f32x16{};
    const int sr = tid >> 4, sc = (tid & 15) * 8, vst0 = v_st(sr, sc), vst1 = v_st(32 + sr, sc);
    const int vb0 = (int)(uintptr_t)V_lds + v_rd_base(lane);
    for (int j = 0; j < 5; ++j) {
        const int kt = t0 - 128 + 64 * j;
        if (kt < 0 || kt >= S_) continue;
        { const bf16* Kg = proj + (size_t)kt * PROJ_LD + C_AK + g * 128 + sc; const bf16* Vg = proj + (size_t)kt * PROJ_LD + C_AV + g * 128 + sc;
          const bf16x8 k0 = *(const bf16x8*)(Kg + (size_t)sr * PROJ_LD), k1 = *(const bf16x8*)(Kg + (size_t)(32 + sr) * PROJ_LD);
          const bf16x8 v0 = *(const bf16x8*)(Vg + (size_t)sr * PROJ_LD), v1 = *(const bf16x8*)(Vg + (size_t)(32 + sr) * PROJ_LD);
          *(bf16x8*)((char*)K_lds + KSWZ(sr, sc * 2)) = k0; *(bf16x8*)((char*)K_lds + KSWZ(32 + sr, sc * 2)) = k1;
          *(bf16x8*)((char*)V_lds + vst0) = v0; *(bf16x8*)((char*)V_lds + vst1) = v1; }
        __syncthreads();
        f32x16 p0 = f32x16{}, p1 = f32x16{};
#pragma unroll
        for (int d0 = 0; d0 < 8; ++d0) { const int cb = (d0 * 16 + hi * 8) * 2;
            const bf16x8 b0 = *(const bf16x8*)((const char*)K_lds + KSWZ(r32, cb));
            const bf16x8 b1 = *(const bf16x8*)((const char*)K_lds + KSWZ(32 + r32, cb));
            p0 = __builtin_amdgcn_mfma_f32_32x32x16_bf16(b0, qr[d0], p0, 0, 0, 0);
            p1 = __builtin_amdgcn_mfma_f32_32x32x16_bf16(b1, qr[d0], p1, 0, 0, 0); }
        if (j == 0 || j == 4) {
#pragma unroll
            for (int r = 0; r < 16; ++r) { const int rel = kt + crow(r, hi) - qrow; if (rel < -128 || rel > 128) p0[r] = NEG; if (rel + 32 < -128 || rel + 32 > 128) p1[r] = NEG; } }
        float pmax = p0[0];
#pragma unroll
        for (int r = 1; r < 16; ++r) pmax = fmaxf(pmax, p0[r]);
#pragma unroll
        for (int r = 0; r < 16; ++r) pmax = fmaxf(pmax, p1[r]);
        { auto rr = __builtin_amdgcn_permlane32_swap(__float_as_uint(pmax), __float_as_uint(pmax), false, false); pmax = fmaxf(__uint_as_float(rr[0]), __uint_as_float(rr[1])); }
        const float mn = fmaxf(m_reg, pmax), alpha = __builtin_amdgcn_exp2f((m_reg - mn) * C); m_reg = mn;
        const float mnC = -mn * C;
#pragma unroll
        for (int r = 0; r < 16; ++r) { p0[r] = __builtin_amdgcn_exp2f(fmaf(p0[r], C, mnC)); p1[r] = __builtin_amdgcn_exp2f(fmaf(p1[r], C, mnC)); }
        float ps = 0.f;
#pragma unroll
        for (int r = 0; r < 16; ++r) ps += p0[r] + p1[r];
        { auto rr = __builtin_amdgcn_permlane32_swap(__float_as_uint(ps), __float_as_uint(ps), false, false); ps = __uint_as_float(rr[0]) + __uint_as_float(rr[1]); }
        l_reg = l_reg * alpha + ps;
        if (__any(alpha < 1.f)) { if (hi == 0) al_l[r32] = alpha; LDS_WAIT();
#pragma unroll
            for (int d = 0; d < 4; ++d)
#pragma unroll
                for (int r = 0; r < 16; ++r) o[d][r] *= al_l[crow(r, hi)]; }
        bf16x8 pa0, pa1, pa2, pa3;
#define PK4(P, BASE, OUT) do { unsigned a0 = cvtpk(P[BASE + 0], P[BASE + 1]), a1 = cvtpk(P[BASE + 2], P[BASE + 3]);   \
    unsigned b0 = cvtpk(P[BASE + 4], P[BASE + 5]), b1 = cvtpk(P[BASE + 6], P[BASE + 7]);                              \
    auto r0 = __builtin_amdgcn_permlane32_swap(a0, b0, false, false); auto r1 = __builtin_amdgcn_permlane32_swap(a1, b1, false, false); \
    u32x4 w = {r0[0], r1[0], r0[1], r1[1]}; OUT = *reinterpret_cast<bf16x8*>(&w); } while (0)
        PK4(p0, 0, pa0); PK4(p0, 8, pa1); PK4(p1, 0, pa2); PK4(p1, 8, pa3);
#undef PK4
        SBAR();
        pv_one<0>(o[0], vb0, pa0, pa1, pa2, pa3); pv_one<1>(o[1], vb0, pa0, pa1, pa2, pa3); pv_one<2>(o[2], vb0, pa0, pa1, pa2, pa3); pv_one<3>(o[3], vb0, pa0, pa1, pa2, pa3);
        __syncthreads();
    }
    if (hi == 0) li_l[r32] = l_reg; LDS_WAIT();
#pragma unroll
    for (int r = 0; r < 16; ++r) { const int orow = crow(r, hi); const float rl = __builtin_amdgcn_rcpf(li_l[orow]);
#pragma unroll
        for (int d0 = 0; d0 < 4; ++d0) stg[orow * 128 + d0 * 32 + r32] = (bf16)f2bf(o[d0][r] * rl); }
    LDS_WAIT();
#pragma unroll
    for (int i = 0; i < 8; ++i) { const int row = i * 4 + (lane >> 4), ch = lane & 15; const u32x4 v = *(const u32x4*)(stg + row * 128 + ch * 8);
        const int tok = t0 + 32 * (wid & 1) + row;
        *(u32x4*)(araw + (size_t)tok * 1024 + hq * 128 + ch * 8) = v;
        float s = bflo(v.x) * bflo(v.x) + bfhi(v.x) * bfhi(v.x) + bflo(v.y) * bflo(v.y) + bfhi(v.y) * bfhi(v.y) + bflo(v.z) * bflo(v.z) + bfhi(v.z) * bfhi(v.z) + bflo(v.w) * bflo(v.w) + bfhi(v.w) * bfhi(v.w);
        s += __shfl_xor(s, 1); s += __shfl_xor(s, 2); s += __shfl_xor(s, 4); s += __shfl_xor(s, 8);
        if (ch == 0) assq[tok * 8 + hq] = s; }
    __syncthreads();
}


constexpr int GL_BIAS = 0, GL_QD = 512, GL_KI = GL_QD + 17408, GL_KET = GL_KI + 17408, GL_VR = GL_KET + 18432, GL_ATT = GL_VR + 36864, GL_DEC = GL_ATT + 9216;
template <int OFF> __device__ __forceinline__ s16x4 tr_read_g(int vb) { s16x4 r; asm volatile("ds_read_b64_tr_b16 %0, %1 offset:%2" : "=&v"(r) : "v"(vb), "i"(OFF) : "memory"); return r; }
#define DPP_ADD(v, ctrl, rmask) v += __builtin_bit_cast(float, __builtin_amdgcn_update_dpp(0, __builtin_bit_cast(int, v), ctrl, rmask, 0xF, false))
template <int PASS> __device__ __forceinline__ void gla_unit(const Args& a, unsigned char* lds, int dir, int head, int sc) {
    const int tid = opaque_tid(), wid = __builtin_amdgcn_readfirstlane(tid >> 6), lane = tid & 63, r32 = lane & 31, hi = lane >> 5;
    const bf16* proj = (const bf16*)(a.ws + WS_PROJ);
    float* BIAS = (float*)(lds + GL_BIAS); float* DEC = (float*)(lds + GL_DEC);
    char* QD = (char*)(lds + GL_QD); char* KI = (char*)(lds + GL_KI); char* KET = (char*)(lds + GL_KET); char* VR = (char*)(lds + GL_VR); char* ATT = (char*)(lds + GL_ATT);
    const float* upg = a.in[dir ? I_UPB : I_UPF];
    if (tid < 128) BIAS[tid] = a.in[dir ? I_BB : I_BF][head * 128 + tid];
    bf16x8 Aup;
    { float u[8];
#pragma unroll
      for (int jj = 0; jj < 8; ++jj) u[jj] = (r32 < 16) ? upg[(8 * hi + jj) * 512 + head * 128 + 16 * wid + r32] : 0.f;
      u32x4 w; w.x = pk2(u[0], u[1]); w.y = pk2(u[2], u[3]); w.z = pk2(u[4], u[5]); w.w = pk2(u[6], u[7]); Aup = __builtin_bit_cast(bf16x8, w); }
    const int dh = dir * 4 + head;
    f32x16 St[4];
    if (PASS == 3) { const float* sin_st = (const float*)(a.ws + WS_SIN_ST) + ((size_t)dh * 32 + sc) * 32768;
#pragma unroll
        for (int db = 0; db < 4; ++db)
#pragma unroll
            for (int r = 0; r < 16; ++r) St[db][r] = sin_st[(32 * db + crow(r, hi)) * 256 + 32 * wid + r32];
    } else { St[0] = f32x16{}; St[1] = f32x16{}; St[2] = f32x16{}; St[3] = f32x16{}; }
    float bsum[8];
#pragma unroll
    for (int c = 0; c < 8; ++c) bsum[c] = 0.f;
    u32x4 rq[2], rk[2], rv[4], rl[2];
#define GLA_TOK(CI, ROW) (dir ? (S_ - 1 - (sc * 512 + (CI) * 64 + (ROW))) : (sc * 512 + (CI) * 64 + (ROW)))
#define GLA_LOAD(CI) do { \
        _Pragma("unroll") for (int i_ = 0; i_ < 2; ++i_) { const int c_ = tid + 512 * i_, row_ = c_ >> 4, ch_ = c_ & 15; const bf16* p_ = proj + (size_t)GLA_TOK(CI, row_) * PROJ_LD + head * 128 + ch_ * 8; \
            rk[i_] = *(const u32x4*)(p_ + C_GK); if (PASS == 3) rq[i_] = *(const u32x4*)(p_ + C_GQ); } \
        _Pragma("unroll") for (int i_ = 0; i_ < 4; ++i_) { const int c_ = tid + 512 * i_, row_ = c_ >> 5, ch_ = c_ & 31; rv[i_] = *(const u32x4*)(proj + (size_t)GLA_TOK(CI, row_) * PROJ_LD + C_GV + head * 256 + ch_ * 8); } \
        _Pragma("unroll") for (int b_ = 0; b_ < 2; ++b_) rl[b_] = *(const u32x4*)(proj + (size_t)GLA_TOK(CI, 32 * b_ + r32) * PROJ_LD + (dir ? C_LRB : C_LRF) + 8 * hi); } while (0)
    GLA_LOAD(0);
    const int vb = (int)(uintptr_t)VR + (8 * hi + ((lane & 15) >> 2)) * 576 + (32 * wid + 16 * ((lane >> 4) & 1) + 4 * (lane & 3)) * 2;
    __syncthreads();
#pragma unroll 1
    for (int ci = 0; ci < 8; ++ci) {
#pragma unroll
        for (int i = 0; i < 2; ++i) { const int c = tid + 512 * i, row = c >> 4, ch = c & 15; *(u32x4*)(KI + row * 272 + ch * 16) = rk[i]; if (PASS == 3) *(u32x4*)(QD + row * 272 + ch * 16) = rq[i]; }
#pragma unroll
        for (int i = 0; i < 4; ++i) { const int c = tid + 512 * i, row = c >> 5, ch = c & 31; *(u32x4*)(VR + row * 576 + ch * 16) = rv[i]; }
        const bf16x8 lrB0 = __builtin_bit_cast(bf16x8, rl[0]), lrB1 = __builtin_bit_cast(bf16x8, rl[1]);
        { const int cn = ci < 7 ? ci + 1 : 7; GLA_LOAD(cn); }
        __syncthreads();
        {
          f32x16 g0 = __builtin_amdgcn_mfma_f32_32x32x16_bf16(Aup, lrB0, f32x16{}, 0, 0, 0), g1 = __builtin_amdgcn_mfma_f32_32x32x16_bf16(Aup, lrB1, f32x16{}, 0, 0, 0);
          const f32x4 bia = *(const f32x4*)(BIAS + 16 * wid + 4 * hi), bib = *(const f32x4*)(BIAS + 16 * wid + 8 + 4 * hi);
          float b0[8], b1[8];
#pragma unroll
          for (int j = 0; j < 8; ++j) { const float bi = j < 4 ? bia[j & 3] : bib[j & 3];
              float x0 = g0[j] + bi, x1 = g1[j] + bi;
              x0 = (fminf(x0, 0.f) - __logf(1.f + __expf(-fabsf(x0)))) * (1.f / 16.f); x1 = (fminf(x1, 0.f) - __logf(1.f + __expf(-fabsf(x1)))) * (1.f / 16.f);
              DPP_ADD(x0, 0x111, 0xF); DPP_ADD(x0, 0x112, 0xF); DPP_ADD(x0, 0x114, 0xF); DPP_ADD(x0, 0x118, 0xF); DPP_ADD(x0, 0x142, 0xA);
              DPP_ADD(x1, 0x111, 0xF); DPP_ADD(x1, 0x112, 0xF); DPP_ADD(x1, 0x114, 0xF); DPP_ADD(x1, 0x118, 0xF); DPP_ADD(x1, 0x142, 0xA);
              const float t0a = __builtin_bit_cast(float, __builtin_amdgcn_readlane(__builtin_bit_cast(int, x0), 31)), t0b = __builtin_bit_cast(float, __builtin_amdgcn_readlane(__builtin_bit_cast(int, x0), 63));
              x1 += hi ? t0b : t0a;
              b0[j] = x0; b1[j] = x1; }
          float blast[8];
#pragma unroll
          for (int j = 0; j < 8; ++j) { const float la = __builtin_bit_cast(float, __builtin_amdgcn_readlane(__builtin_bit_cast(int, b1[j]), 31)), lb = __builtin_bit_cast(float, __builtin_amdgcn_readlane(__builtin_bit_cast(int, b1[j]), 63));
              blast[j] = hi ? lb : la; bsum[j] += blast[j]; }
          float dec[8];
#pragma unroll
          for (int j = 0; j < 8; ++j) dec[j] = __expf(blast[j]);
          if (r32 == 0) { *(f32x4*)(DEC + 16 * wid + 4 * hi) = (f32x4){dec[0], dec[1], dec[2], dec[3]}; *(f32x4*)(DEC + 16 * wid + 8 + 4 * hi) = (f32x4){dec[4], dec[5], dec[6], dec[7]}; }
#pragma unroll
          for (int blk = 0; blk < 2; ++blk) { const int tok = 32 * blk + r32; const float* bb = blk ? b1 : b0;
              char* kp = KI + tok * 272 + (16 * wid + 4 * hi) * 2; const u32x2 ka = *(const u32x2*)kp, kb = *(const u32x2*)(kp + 16);
              const float kf[8] = {bflo(ka.x), bfhi(ka.x), bflo(ka.y), bfhi(ka.y), bflo(kb.x), bfhi(kb.x), bflo(kb.y), bfhi(kb.y)};
              float ki[8];
#pragma unroll
              for (int j = 0; j < 8; ++j) ki[j] = kf[j] * __expf(-bb[j]);
              bf16* ket = (bf16*)KET + (16 * wid + 4 * hi) * 72 + tok;
#pragma unroll
              for (int j = 0; j < 8; ++j) ket[((j & 3) + 8 * (j >> 2)) * 72] = (bf16)f2bf(ki[j] * dec[j]);
              if (PASS == 3) {
                  u32x2 wa, wb; wa.x = pk2(ki[0], ki[1]); wa.y = pk2(ki[2], ki[3]); wb.x = pk2(ki[4], ki[5]); wb.y = pk2(ki[6], ki[7]);
                  *(u32x2*)kp = wa; *(u32x2*)(kp + 16) = wb;
                  char* qp = QD + tok * 272 + (16 * wid + 4 * hi) * 2; const u32x2 qa = *(const u32x2*)qp, qb = *(const u32x2*)(qp + 16);
                  const float qf[8] = {bflo(qa.x), bfhi(qa.x), bflo(qa.y), bfhi(qa.y), bflo(qb.x), bfhi(qb.x), bflo(qb.y), bfhi(qb.y)};
                  float qd[8];
#pragma unroll
                  for (int j = 0; j < 8; ++j) qd[j] = qf[j] * 0.088388347648318440f * __expf(bb[j]);
                  wa.x = pk2(qd[0], qd[1]); wa.y = pk2(qd[2], qd[3]); wb.x = pk2(qd[4], qd[5]); wb.y = pk2(qd[6], qd[7]);
                  *(u32x2*)qp = wa; *(u32x2*)(qp + 16) = wb; } }
        }
        __syncthreads();
        f32x16 oT[2]; oT[0] = f32x16{}; oT[1] = f32x16{};
        if (PASS == 3) {
#pragma unroll
            for (int e = 0; e < 2; ++e) { const int blk = 2 * wid + e, jb = blk >> 2, cb = blk & 3; const int l15 = lane & 15, l4 = lane >> 4;
                f32x4 acc = {0.f, 0.f, 0.f, 0.f};
                if (jb <= cb) {
#pragma unroll
                    for (int ks = 0; ks < 4; ++ks) { const bf16x8 A = *(const bf16x8*)(KI + (16 * jb + l15) * 272 + (8 * l4 + 32 * ks) * 2); const bf16x8 B = *(const bf16x8*)(QD + (16 * cb + l15) * 272 + (8 * l4 + 32 * ks) * 2);
                        acc = __builtin_amdgcn_mfma_f32_16x16x32_bf16(A, B, acc, 0, 0, 0); }
                    const int c = 16 * cb + l15, j0 = 16 * jb + 4 * l4;
#pragma unroll
                    for (int r = 0; r < 4; ++r) if (j0 + r > c) acc[r] = 0.f;
                }
                u32x2 w; w.x = pk2(acc[0], acc[1]); w.y = pk2(acc[2], acc[3]);
                *(u32x2*)(ATT + (16 * cb + l15) * 144 + (16 * jb + 4 * l4) * 2) = w; }
            __syncthreads();
        }
        bf16x8 Vf[4];
        { const s16x4 a0 = tr_read_g<0>(vb), c0 = tr_read_g<2304>(vb), a1 = tr_read_g<9216>(vb), c1 = tr_read_g<9216 + 2304>(vb);
          const s16x4 a2 = tr_read_g<18432>(vb), c2 = tr_read_g<18432 + 2304>(vb), a3 = tr_read_g<27648>(vb), c3 = tr_read_g<27648 + 2304>(vb);
          asm volatile("s_waitcnt lgkmcnt(0)" ::: "memory"); SBAR();
          Vf[0] = (bf16x8){a0[0], a0[1], a0[2], a0[3], c0[0], c0[1], c0[2], c0[3]}; Vf[1] = (bf16x8){a1[0], a1[1], a1[2], a1[3], c1[0], c1[1], c1[2], c1[3]};
          Vf[2] = (bf16x8){a2[0], a2[1], a2[2], a2[3], c2[0], c2[1], c2[2], c2[3]}; Vf[3] = (bf16x8){a3[0], a3[1], a3[2], a3[3], c3[0], c3[1], c3[2], c3[3]}; }
        if (PASS == 3) {
#pragma unroll
            for (int cb2 = 0; cb2 < 2; ++cb2) {
#pragma unroll
                for (int ks = 0; ks < 4; ++ks) { if (cb2 == 0 && ks >= 2) continue;
                    const bf16x8 B = *(const bf16x8*)(ATT + (32 * cb2 + r32) * 144 + (16 * ks + 8 * hi) * 2);
                    oT[cb2] = __builtin_amdgcn_mfma_f32_32x32x16_bf16(Vf[ks], B, oT[cb2], 0, 0, 0); }
#pragma unroll
                for (int db = 0; db < 4; ++db)
#pragma unroll
                    for (int s = 0; s < 2; ++s) { u32x4 sw; sw.x = cvtpk(St[db][8 * s + 0], St[db][8 * s + 1]); sw.y = cvtpk(St[db][8 * s + 2], St[db][8 * s + 3]); sw.z = cvtpk(St[db][8 * s + 4], St[db][8 * s + 5]); sw.w = cvtpk(St[db][8 * s + 6], St[db][8 * s + 7]);
                        const char* qp = QD + (32 * cb2 + r32) * 272 + (32 * db + 16 * s + 4 * hi) * 2; const u32x2 blo = *(const u32x2*)qp, bhi2 = *(const u32x2*)(qp + 16);
                        const u32x4 bw = {blo.x, blo.y, bhi2.x, bhi2.y};
                        oT[cb2] = __builtin_amdgcn_mfma_f32_32x32x16_bf16(__builtin_bit_cast(bf16x8, sw), __builtin_bit_cast(bf16x8, bw), oT[cb2], 0, 0, 0); }
            }
        }
#pragma unroll
        for (int db = 0; db < 4; ++db) {
#pragma unroll
            for (int g4 = 0; g4 < 4; ++g4) { const f32x4 dv = *(const f32x4*)(DEC + 32 * db + 8 * g4 + 4 * hi); St[db][4 * g4 + 0] *= dv[0]; St[db][4 * g4 + 1] *= dv[1]; St[db][4 * g4 + 2] *= dv[2]; St[db][4 * g4 + 3] *= dv[3]; }
#pragma unroll
            for (int ks = 0; ks < 4; ++ks) { const bf16x8 A = *(const bf16x8*)(KET + (32 * db + r32) * 144 + (16 * ks + 8 * hi) * 2);
                St[db] = __builtin_amdgcn_mfma_f32_32x32x16_bf16(A, Vf[ks], St[db], 0, 0, 0); }
        }
        if (PASS == 3) { bf16* od = (bf16*)(a.ws + WS_OF) + (size_t)dir * S_ * 1024;
#pragma unroll
            for (int cb2 = 0; cb2 < 2; ++cb2) { const int t = GLA_TOK(ci, 32 * cb2 + r32); bf16* op = od + (size_t)t * 1024 + head * 256 + 32 * wid + 8 * hi;
#pragma unroll
                for (int p = 0; p < 2; ++p) {
                    const unsigned ax = cvtpk(oT[cb2][8 * p + 0], oT[cb2][8 * p + 1]), ay = cvtpk(oT[cb2][8 * p + 2], oT[cb2][8 * p + 3]);
                    const unsigned bx = cvtpk(oT[cb2][8 * p + 4], oT[cb2][8 * p + 5]), by = cvtpk(oT[cb2][8 * p + 6], oT[cb2][8 * p + 7]);
                    auto r0 = __builtin_amdgcn_permlane32_swap(ax, bx, false, false); auto r1 = __builtin_amdgcn_permlane32_swap(ay, by, false, false);
                    const u32x4 w = {r0[0], r1[0], r0[1], r1[1]};
                    *(u32x4*)(op + 16 * p) = w; } } }
        __syncthreads();
    }
#undef GLA_LOAD
#undef GLA_TOK
    if (PASS == 1) { float* ds = (float*)(a.ws + WS_DS) + ((size_t)dh * 32 + sc) * 32768;
#pragma unroll
        for (int db = 0; db < 4; ++db)
#pragma unroll
            for (int r = 0; r < 16; ++r) ds[(32 * db + crow(r, hi)) * 256 + 32 * wid + r32] = St[db][r];
        if (r32 == 0) { float* dt = (float*)(a.ws + WS_DECT) + (dh * 32 + sc) * 128 + 16 * wid + 4 * hi;
#pragma unroll
            for (int j = 0; j < 8; ++j) dt[(j & 3) + 8 * (j >> 2)] = __expf(bsum[j]); } }
}
#undef DPP_ADD
__device__ __forceinline__ void gla_scan(const Args& a, int G) {
    const float* ds = (const float*)(a.ws + WS_DS); const float* dt = (const float*)(a.ws + WS_DECT); float* si = (float*)(a.ws + WS_SIN_ST);
    const int gt = blockIdx.x * NTHREADS + threadIdx.x, NGT = G * NTHREADS;
    for (int idx = gt; idx < 8 * 32768; idx += NGT) { const int dh = idx >> 15, el = idx & 32767, d = el >> 8;
        float x[32], dc[32];
#pragma unroll
        for (int sc = 0; sc < 32; ++sc) { x[sc] = ds[((size_t)dh * 32 + sc) * 32768 + el]; dc[sc] = dt[(dh * 32 + sc) * 128 + d]; }
        float s = 0.f;
#pragma unroll
        for (int sc = 0; sc < 32; ++sc) { si[((size_t)dh * 32 + sc) * 32768 + el] = s; s = dc[sc] * s + x[sc]; } }
}

__device__ __forceinline__ void finalize_mixed(const Args& a, int wave, int lane, int G) {
    unsigned char* mixed = a.ws + WS_MIX; float* sam = (float*)(a.ws + WS_SAM); const bf16* araw = (const bf16*)(a.ws + WS_ARAW); const float* assq = (const float*)(a.ws + WS_ASSQ); const bf16* proj = (const bf16*)(a.ws + WS_PROJ);
    const bf16* of = (const bf16*)(a.ws + WS_OF); const bf16* ob = of + (size_t)S_ * 1024;
    const int gw = blockIdx.x * NWAVES + wave, NGW = G * NWAVES; const int hi = lane >> 5, l31 = lane & 31;
    float anw[16], gnw[8];
#pragma unroll
    for (int i = 0; i < 2; ++i)
#pragma unroll
        for (int e = 0; e < 8; ++e) anw[i * 8 + e] = a.in[I_ANW][512 * i + lane * 8 + e];
#pragma unroll
    for (int e = 0; e < 8; ++e) gnw[e] = a.in[I_GNW][l31 * 8 + e];
    for (int t = gw; t < S_; t += NGW) {
        u32x4 va[2], vf[2], vb[2], vg[2];
#pragma unroll
        for (int i = 0; i < 2; ++i) va[i] = *(const GAS u32x4*)(araw + (size_t)t * 1024 + 512 * i + lane * 8);
#pragma unroll
        for (int j = 0; j < 2; ++j) { const int c = (2 * j + hi) * 256 + 8 * l31; vf[j] = *(const GAS u32x4*)(of + (size_t)t * 1024 + c); vb[j] = *(const GAS u32x4*)(ob + (size_t)t * 1024 + c); vg[j] = *(const GAS u32x4*)(proj + (size_t)t * PROJ_LD + C_GR + c); }
        const float tot = wave_sum(lane < 8 ? assq[t * 8 + lane] : 0.f);
        const float rstd = 1.f / sqrtf(tot * (1.f / 1024.f) + EPS_);
        float av[16], gv[16]; float mx = 0.f;
#pragma unroll
        for (int i = 0; i < 2; ++i) { const u32x4 v = va[i]; const float* w = anw + i * 8; float* o = av + i * 8;
            o[0] = bflo(v.x) * rstd * w[0]; o[1] = bfhi(v.x) * rstd * w[1]; o[2] = bflo(v.y) * rstd * w[2]; o[3] = bfhi(v.y) * rstd * w[3];
            o[4] = bflo(v.z) * rstd * w[4]; o[5] = bfhi(v.z) * rstd * w[5]; o[6] = bflo(v.w) * rstd * w[6]; o[7] = bfhi(v.w) * rstd * w[7]; }
#pragma unroll
        for (int j = 0; j < 2; ++j) { const u32x4 f = vf[j], b = vb[j], g = vg[j];
            float o8[8] = {bflo(f.x) + bflo(b.x), bfhi(f.x) + bfhi(b.x), bflo(f.y) + bflo(b.y), bfhi(f.y) + bfhi(b.y), bflo(f.z) + bflo(b.z), bfhi(f.z) + bfhi(b.z), bflo(f.w) + bflo(b.w), bfhi(f.w) + bfhi(b.w)};
            const float gg[8] = {bflo(g.x), bfhi(g.x), bflo(g.y), bfhi(g.y), bflo(g.z), bfhi(g.z), bflo(g.w), bfhi(g.w)};
            float ss = 0.f;
#pragma unroll
            for (int e = 0; e < 8; ++e) ss += o8[e] * o8[e];
            ss += WV_DPP(ss, 0x111, 0xF); ss += WV_DPP(ss, 0x112, 0xF); ss += WV_DPP(ss, 0x114, 0xF); ss += WV_DPP(ss, 0x118, 0xF); ss += WV_DPP(ss, 0x142, 0xA);
            const float slo = __builtin_bit_cast(float, __builtin_amdgcn_readlane(__builtin_bit_cast(int, ss), 31)), shi = __builtin_bit_cast(float, __builtin_amdgcn_readlane(__builtin_bit_cast(int, ss), 63));
            const float rs = 1.f / sqrtf((hi ? shi : slo) * (1.f / 256.f) + EPS_);
#pragma unroll
            for (int e = 0; e < 8; ++e) gv[j * 8 + e] = o8[e] * rs * gnw[e] * pg8::silu_f(gg[e]); }
#pragma unroll
        for (int e = 0; e < 16; ++e) mx = fmaxf(mx, fmaxf(fabsf(av[e]), fabsf(gv[e])));
        mx = wave_max(mx); const float inv = mx > 0.f ? 127.f / mx : 0.f;
        if (lane == 0) sam[t] = mx * (1.f / 127.f);
#pragma unroll
        for (int i = 0; i < 2; ++i) { u32x2 w; w.x = pk4_i8(av[i * 8 + 0] * inv, av[i * 8 + 1] * inv, av[i * 8 + 2] * inv, av[i * 8 + 3] * inv); w.y = pk4_i8(av[i * 8 + 4] * inv, av[i * 8 + 5] * inv, av[i * 8 + 6] * inv, av[i * 8 + 7] * inv);
            *(GAS u32x2*)(mixed + (size_t)t * DM + 512 * i + lane * 8) = w; }
#pragma unroll
        for (int j = 0; j < 2; ++j) { u32x2 w; w.x = pk4_i8(gv[j * 8 + 0] * inv, gv[j * 8 + 1] * inv, gv[j * 8 + 2] * inv, gv[j * 8 + 3] * inv); w.y = pk4_i8(gv[j * 8 + 4] * inv, gv[j * 8 + 5] * inv, gv[j * 8 + 6] * inv, gv[j * 8 + 7] * inv);
            *(GAS u32x2*)(mixed + (size_t)t * DM + 1024 + (2 * j + hi) * 256 + 8 * l31) = w; }
    }
}

__device__ __forceinline__ void router_block(const Args& a, unsigned char* lds, int tb) {
    const int tid = opaque_tid(), wid = __builtin_amdgcn_readfirstlane(tid >> 6), lane = tid & 63, l15 = lane & 15, l4 = lane >> 4;
    const bf16* h = (const bf16*)(a.ws + WS_H); const float* lw = a.in[I_LN2];
    unsigned char* xn2 = a.ws + WS_XN2; const bf16* wr = (const bf16*)(a.ws + WS_WR);
    char* At = (char*)lds;
    float* part = (float*)lds;
    float* rsl = (float*)(lds + 100352); int* cntl = (int*)(lds + 100352 + 256);
    pg8::f32x4 acc[4][3];
#pragma unroll
    for (int rb = 0; rb < 4; ++rb)
#pragma unroll
        for (int nb = 0; nb < 3; ++nb) acc[rb][nb] = (pg8::f32x4){0.f, 0.f, 0.f, 0.f};
    float ssq[8];
#pragma unroll
    for (int rr = 0; rr < 8; ++rr) ssq[rr] = 0.f;
    u32x4 hn[8];
#pragma unroll
    for (int rr = 0; rr < 8; ++rr) hn[rr] = *(const u32x4*)(h + ((size_t)tb * 64 + 8 * wid + rr) * DM + 8 * lane);
#pragma unroll 1
    for (int kc = 0; kc < 4; ++kc) {
        const f32x4 w0 = *(const f32x4*)(lw + kc * 512 + 8 * lane), w1 = *(const f32x4*)(lw + kc * 512 + 8 * lane + 4);
#pragma unroll
        for (int rr = 0; rr < 8; ++rr) { const int row = 8 * wid + rr; const size_t t = (size_t)tb * 64 + row;
            const u32x4 hv = hn[rr];
            const float f0 = bflo(hv.x), f1 = bfhi(hv.x), f2 = bflo(hv.y), f3 = bfhi(hv.y), f4 = bflo(hv.z), f5 = bfhi(hv.z), f6 = bflo(hv.w), f7 = bfhi(hv.w);
            ssq[rr] += (f0 * f0 + f1 * f1) + (f2 * f2 + f3 * f3) + (f4 * f4 + f5 * f5) + (f6 * f6 + f7 * f7);
            const float a0 = f0 * w0.x, a1 = f1 * w0.y, a2 = f2 * w0.z, a3 = f3 * w0.w, a4 = f4 * w1.x, a5 = f5 * w1.y, a6 = f6 * w1.z, a7 = f7 * w1.w;
            u32x4 p; p.x = pk2(a0, a1); p.y = pk2(a2, a3); p.z = pk2(a4, a5); p.w = pk2(a6, a7);
            *(u32x4*)(At + row * 1040 + (8 * lane) * 2) = p;
            u32x2 q8; q8.x = pg8::pk4_fp8(a0, a1, a2, a3); q8.y = pg8::pk4_fp8(a4, a5, a6, a7);
            *(u32x2*)(xn2 + t * XN2_P + kc * 512 + 8 * lane) = q8; }
        { const int kn = kc < 3 ? kc + 1 : 3;
#pragma unroll
          for (int rr = 0; rr < 8; ++rr) hn[rr] = *(const u32x4*)(h + ((size_t)tb * 64 + 8 * wid + rr) * DM + kn * 512 + 8 * lane); }
        bf16x8 B[2][3];
#pragma unroll
        for (int k2 = 0; k2 < 2; ++k2)
#pragma unroll
            for (int nb = 0; nb < 3; ++nb) B[k2][nb] = *(const bf16x8*)(wr + (size_t)(16 * nb + l15) * DM + kc * 512 + 32 * (2 * wid + k2) + 8 * l4);
        __syncthreads();
#pragma unroll
        for (int k2 = 0; k2 < 2; ++k2) { const int ks = 2 * wid + k2;
#pragma unroll
            for (int rb = 0; rb < 4; ++rb) { const bf16x8 A = *(const bf16x8*)(At + (16 * rb + l15) * 1040 + (32 * ks + 8 * l4) * 2);
#pragma unroll
                for (int nb = 0; nb < 3; ++nb) acc[rb][nb] = __builtin_amdgcn_mfma_f32_16x16x32_bf16(A, B[k2][nb], acc[rb][nb], 0, 0, 0); } }
        __syncthreads();
    }
#pragma unroll
    for (int rr = 0; rr < 8; ++rr) { const float s = wave_sum(ssq[rr]); if (lane == 0) rsl[8 * wid + rr] = 1.f / sqrtf(s * (1.f / DM) + EPS_); }
#pragma unroll
    for (int rb = 0; rb < 4; ++rb)
#pragma unroll
        for (int nb = 0; nb < 3; ++nb)
#pragma unroll
            for (int r = 0; r < 4; ++r) part[(wid * 64 + 16 * rb + 4 * l4 + r) * 48 + 16 * nb + l15] = acc[rb][nb][r];
    if (tid < 32) cntl[tid] = 0;
    __syncthreads();
    if (tid < 64) { const int token = tb * 64 + tid; const float rstd = rsl[tid];
        float gl[4];
#pragma unroll
        for (int n = 0; n < 4; ++n) { float s = 0.f;
#pragma unroll
            for (int w = 0; w < 8; ++w) s += part[(w * 64 + tid) * 48 + n];
            gl[n] = s * rstd + a.in[I_BG][n]; }
        int gs = 0; float gm = gl[0];
#pragma unroll
        for (int n = 1; n < 4; ++n) if (gl[n] > gm) { gm = gl[n]; gs = n; }
        float den = 0.f;
#pragma unroll
        for (int n = 0; n < 4; ++n) den += __expf(gl[n] - gm);
        const float gate = 1.f / den;
        float el[8];
#pragma unroll
        for (int j = 0; j < 8; ++j) { float s = 0.f;
#pragma unroll
            for (int w = 0; w < 8; ++w) s += part[(w * 64 + tid) * 48 + 4 + gs * 8 + j];
            el[j] = s * rstd + a.in[I_BR][gs * 8 + j]; }
        int i0 = 0; float v0 = el[0];
#pragma unroll
        for (int j = 1; j < 8; ++j) if (el[j] > v0) { v0 = el[j]; i0 = j; }
        int i1 = -1; float v1 = -3.0e38f;
#pragma unroll
        for (int j = 0; j < 8; ++j) if (j != i0 && el[j] > v1) { v1 = el[j]; i1 = j; }
        const float ex = __expf(v1 - v0), p0 = 1.f / (1.f + ex), p1 = ex * p0;
        int* te = (int*)(a.ws + WS_TOKE); float* tw = (float*)(a.ws + WS_TOKW); float* tr = (float*)(a.ws + WS_TOKR);
        te[token * 2] = gs * 8 + i0; te[token * 2 + 1] = gs * 8 + i1; tw[token * 2] = gate * p0; tw[token * 2 + 1] = gate * p1; tr[token] = rstd;
        atomicAdd(&cntl[gs * 8 + i0], 1); atomicAdd(&cntl[gs * 8 + i1], 1); }
    __syncthreads();
    if (tid < 32) ((int*)(a.ws + WS_CNT))[tb * 32 + tid] = cntl[tid];
    __syncthreads();
}
__device__ __forceinline__ void assign_block(const Args& a, unsigned char* lds, int tb) {
    const int tid = opaque_tid(), wid = __builtin_amdgcn_readfirstlane(tid >> 6), lane = tid & 63;
    const int* cnt = (const int*)(a.ws + WS_CNT); const int* te = (const int*)(a.ws + WS_TOKE); const float* tw = (const float*)(a.ws + WS_TOKW); const float* tr = (const float*)(a.ws + WS_TOKR);
    int* sdst = (int*)(a.ws + WS_SDST); float* sw = (float*)(a.ws + WS_SW); float* srs = (float*)(a.ws + WS_SRS); int* tile_e = (int*)(a.ws + WS_TILEE);
    int* L_tot = (int*)lds; int* L_bef = L_tot + 32; int* L_ps = L_bef + 32; int* L_base = L_ps + 40; int* L_e = L_base + 32; int* L_slot = L_e + 128;
    { int* L_pt = L_slot + 128; int* L_pb = L_pt + 512;
      const int e = tid & 31, seg = tid >> 5; int tot = 0, bef = 0;
#pragma unroll
      for (int i = 0; i < 16; ++i) { const int b = seg * 16 + i; const int c = cnt[b * 32 + e]; tot += c; bef += (b < tb) ? c : 0; }
      L_pt[tid] = tot; L_pb[tid] = bef; }
    __syncthreads();
    if (tid < 32) { int tot = 0, bef = 0;
#pragma unroll
        for (int s = 0; s < 16; ++s) { tot += L_slot[128 + s * 32 + tid]; bef += L_slot[128 + 512 + s * 32 + tid]; }
        L_tot[tid] = tot; L_bef[tid] = bef; }
    __syncthreads();
    if (tid == 0) { int p = 0; for (int e = 0; e < 32; ++e) { L_ps[e] = p; L_base[e] = p + L_bef[e]; p += (L_tot[e] + 255) & ~255; } L_ps[32] = p; }
    if (tid < 128) L_e[tid] = te[tb * 128 + tid];
    __syncthreads();
    if (tid < 128) { const int e = L_e[tid]; int rank = 0; for (int a2 = 0; a2 < tid; ++a2) rank += (L_e[a2] == e) ? 1 : 0;
        const int slot = L_base[e] + rank, token = tb * 64 + (tid >> 1), k = tid & 1; L_slot[tid] = slot;
        sdst[slot] = k * S_ + token; sw[slot] = tw[token * 2 + k]; srs[slot] = tr[token]; }
    __syncthreads();
    if (tb == 0) {
        for (int e = 0; e < 32; ++e) { const int st = L_ps[e] + L_tot[e], en = L_ps[e] + ((L_tot[e] + 255) & ~255);
            for (int s = st + tid; s < en; s += NTHREADS) { sdst[s] = -1; sw[s] = 0.f; srs[s] = 0.f; } }
        if (tid < 32) { const int t0 = L_ps[tid] >> 8, t1 = (L_ps[tid] + ((L_tot[tid] + 255) & ~255)) >> 8; for (int t = t0; t < t1; ++t) tile_e[t] = tid; }
        if (tid == 0) tile_e[MAX_TILES] = L_ps[32] >> 8;
    }
    __syncthreads();
}

template <int CLS> __device__ __forceinline__ void conv_share(const Args& a, int it0, int nitems, LAS unsigned char* lds, int wave, int lane, int G, int cls) {
    const bool split = (G % 16) == 0; const int b = blockIdx.x;
    if (!split) { if (cls == 0) titem_run<CLS>(a, it0, nitems, b * NWAVES + wave, G * NWAVES, (LAS float*)(lds + wave * 16384), lane); return; }
    if (((b >> 3) & 1) != cls) return;
    const int rank = (b >> 4) * 8 + (b & 7), half = nitems / 2;
    titem_run<CLS>(a, it0 + cls * half, cls ? nitems - half : half, rank * NWAVES + wave, (G / 2) * NWAVES, (LAS float*)(lds + wave * 16384), lane);
}

__global__ void __launch_bounds__(NTHREADS, 2) hymba_fwd(Args args) {
    extern __shared__ __attribute__((aligned(16))) unsigned char lds[];
    LAS unsigned char* ldsl = (LAS unsigned char*)lds;
    const int tid = opaque_tid(), lane = tid & 63, wave = __builtin_amdgcn_readfirstlane(tid >> 6);
    const int G = gridDim.x;
    unsigned char* ws = args.ws;
    for (int u = tid; u < (LDS_BYTES - LDSCTL_OFF) / 4; u += NTHREADS) ((LAS unsigned*)(ldsl + LDSCTL_OFF))[u] = 0u;
    __syncthreads();
    volatile LAS unsigned* MISC = (volatile LAS unsigned*)(ldsl + MISC_OFF);
    LAS unsigned* utab = (LAS unsigned*)(ldsl + TILEE_OFF + 2048);
    XcdBarrier bar = xcd_barrier_post((unsigned*)(ws + WS_CTL) + CW_BAR, MISC + 8);

    p0_prologue(args, ldsl, wave, lane, G);
    xcd_barrier(bar);
    { pg8::Gemm g{ws + WS_XN, ws + WS_WIN, DM, DM, DM, 128, 128, (size_t)256 * DM, (size_t)256 * DM}; pg8::StaticOrder S; S.init(S_, PROJ_LD, G, (int)blockIdx.x);
      { pg8::Unit u; const float* sax = (const float*)(ws + WS_SAX); const float* cmi = (const float*)(ws + WS_CTL) + CW_CMAX_IN;
        for (int i = 0; i < UTAB_UNITS && S.next(i, u); ++i) if (tid < 256) { utab[i * 512 + tid] = __builtin_bit_cast(unsigned, sax[u.pm * 256 + tid]); utab[i * 512 + 256 + tid] = __builtin_bit_cast(unsigned, cmi[u.pn * 256 + tid] * (1.f / 127.f)); } }
      __syncthreads();
      pg8::EpiBf16Q E{(bf16*)(ws + WS_PROJ), PROJ_LD};
      pg8::gemm_phase<pg8::EpiBf16Q, pg8::StaticOrder, 2>(ldsl, g, S, E, utab); }
    {
      const int nfull = (S_ / 256) * (PROJ_LD / 256) % G; const int first = (nfull != 0 && G - nfull >= 1) ? nfull : 0, nhost = G - first;
      __syncthreads();
      for (int s = (int)blockIdx.x - first; s >= 0 && s < 64; s += nhost) p0_strip(args, 145 + s, (LAS float*)(ldsl + wave * 16384), (LAS float*)(ldsl + TILEE_OFF + 1024), wave, lane); }
    xcd_barrier(bar);
    qk_norm_rope(args, wave, lane, G);
#if MK_STAGE >= 2
    __syncthreads();
    conv_share<1>(args, 0, 32 * 512, ldsl, wave, lane, G, 0);
    __syncthreads();
    for (int u = blockIdx.x; u < 256; u += G) gla_unit<1>(args, lds, u >> 7, (u >> 5) & 3, u & 31);
    __syncthreads();
    conv_share<1>(args, 0, 32 * 512, ldsl, wave, lane, G, 1);
#endif
    xcd_barrier(bar);
#if MK_STAGE >= 2
    gla_scan(args, G);
#endif
    __syncthreads();
    conv_share<0>(args, 0, 32 * 512, ldsl, wave, lane, G, 0);
    __syncthreads();
    for (int u = blockIdx.x; u < 512; u += G) attn_unit(args, lds, u >> 1, u & 1);
    __syncthreads();
    conv_share<0>(args, 0, 32 * 512, ldsl, wave, lane, G, 1);
    xcd_barrier(bar);
#if MK_STAGE >= 2
    conv_share<0>(args, 32 * 512, 32 * 512, ldsl, wave, lane, G, 0);
    __syncthreads();
    for (int u = blockIdx.x; u < 256; u += G) gla_unit<3>(args, lds, u >> 7, (u >> 5) & 3, u & 31);
    __syncthreads();
    conv_share<0>(args, 32 * 512, 32 * 512, ldsl, wave, lane, G, 1);
    xcd_barrier(bar);
#endif
    finalize_mixed(args, wave, lane, G);
    xcd_barrier(bar);
    { pg8::Gemm g{ws + WS_MIX, ws + WS_WOUT, DM, DM, DM, 128, 128, (size_t)256 * DM, (size_t)256 * DM}; pg8::StaticOrder S; S.init(S_, DM, G, (int)blockIdx.x);
      pg8::EpiResBf16Q E{(bf16*)(ws + WS_H), args.in[I_X], DM, (const float*)(ws + WS_SAM), (const float*)(ws + WS_CTL) + CW_CMAX_OUT};
      pg8::gemm_phase<pg8::EpiResBf16Q, pg8::StaticOrder, 2>(ldsl, g, S, E, utab); }
#if MK_STAGE >= 3
    xcd_barrier(bar);
    for (int tb = blockIdx.x; tb < 256; tb += G) router_block(args, lds, tb);
    xcd_barrier(bar);
    for (int tb = blockIdx.x; tb < 256; tb += G) assign_block(args, lds, tb);
    xcd_barrier(bar);
    LAS int* tile_lds = (LAS int*)(ldsl + TILEE_OFF);
    if (tid <= MAX_TILES) tile_lds[tid] = ((const int*)(ws + WS_TILEE))[tid];
    __syncthreads();
    const int n_tiles = __builtin_amdgcn_readfirstlane(tile_lds[MAX_TILES]);
    { pg8::Gemm g{ws + WS_XN2, ws + WS_WGU, DM, XN2_P, 128, 128, 32768, 0, (size_t)256 * DM}; pg8::MoeOrder S; S.init(n_tiles, 8, G, (int)blockIdx.x, tile_lds);
      { pg8::Unit u; const int* sdst = (const int*)(ws + WS_SDST); const float* srs = (const float*)(ws + WS_SRS);
        for (int i = 0; i < UTAB_UNITS && S.next(i, u); ++i) if (tid < 256) { const int d = sdst[u.pm * 256 + tid]; utab[i * 512 + tid] = __builtin_bit_cast(unsigned, srs[u.pm * 256 + tid]); utab[i * 512 + 256 + tid] = (unsigned)(d < 0 ? 0 : (d & (S_ - 1))); } }
      __syncthreads();
      pg8::EpiSwiGLU E{ws + WS_HID};
      pg8::gemm_phase<pg8::EpiSwiGLU, pg8::MoeOrder, 1, true>(ldsl, g, S, E, utab); }
    xcd_barrier(bar);
    { pg8::Gemm g{ws + WS_HID, ws + WS_WD, DFF, 128, 128, 32768, 32768, (size_t)256 * DFF, (size_t)256 * DFF}; pg8::MoeOrder S; S.init(n_tiles, 8, G, (int)blockIdx.x, tile_lds);
      { pg8::Unit u; const int* sdst = (const int*)(ws + WS_SDST); const float* sw = (const float*)(ws + WS_SW);
        for (int i = 0; i < UTAB_UNITS && S.next(i, u); ++i) if (tid < 256) { utab[i * 512 + tid] = (unsigned)sdst[u.pm * 256 + tid]; utab[i * 512 + 256 + tid] = __builtin_bit_cast(unsigned, sw[u.pm * 256 + tid]); } }
      __syncthreads();
      pg8::EpiMoeOut E{ws + WS_Y};
      pg8::gemm_phase<pg8::EpiMoeOut, pg8::MoeOrder, 1>(ldsl, g, S, E, utab); }
    xcd_barrier(bar);
    { const int gt = blockIdx.x * NTHREADS + tid, NGT = G * NTHREADS; const unsigned char* Y0 = ws + WS_Y; const unsigned char* Y1 = Y0 + (size_t)S_ * DM; const bf16* H = (const bf16*)(ws + WS_H);
      typedef float f32x2_t __attribute__((ext_vector_type(2)));
      constexpr int NIT = S_ * DM / 8, UNR = 4;
      for (int i0 = gt; i0 < NIT; i0 += NGT * UNR) {
          u32x4 hv[UNR]; u32x2 y0[UNR], y1[UNR];
#pragma unroll
          for (int u = 0; u < UNR; ++u) { const int i = i0 + u * NGT; if (i < NIT) { hv[u] = *((const GAS u32x4*)H + i); y0[u] = *((const GAS u32x2*)Y0 + i); y1[u] = *((const GAS u32x2*)Y1 + i); } }
#pragma unroll
          for (int u = 0; u < UNR; ++u) { const int i = i0 + u * NGT; if (i < NIT) { GAS f32x4* o = (GAS f32x4*)args.out + 2 * (size_t)i;
              const f32x2_t a0 = __builtin_amdgcn_cvt_pk_f32_fp8(y0[u].x, false), a1 = __builtin_amdgcn_cvt_pk_f32_fp8(y0[u].x, true), a2 = __builtin_amdgcn_cvt_pk_f32_fp8(y0[u].y, false), a3 = __builtin_amdgcn_cvt_pk_f32_fp8(y0[u].y, true);
              const f32x2_t b0 = __builtin_amdgcn_cvt_pk_f32_fp8(y1[u].x, false), b1 = __builtin_amdgcn_cvt_pk_f32_fp8(y1[u].x, true), b2 = __builtin_amdgcn_cvt_pk_f32_fp8(y1[u].y, false), b3 = __builtin_amdgcn_cvt_pk_f32_fp8(y1[u].y, true);
              f32x4 r0, r1; r0.x = bflo(hv[u].x) + (a0.x + b0.x) * pg8::YUNSCALE; r0.y = bfhi(hv[u].x) + (a0.y + b0.y) * pg8::YUNSCALE; r0.z = bflo(hv[u].y) + (a1.x + b1.x) * pg8::YUNSCALE; r0.w = bfhi(hv[u].y) + (a1.y + b1.y) * pg8::YUNSCALE;
              r1.x = bflo(hv[u].z) + (a2.x + b2.x) * pg8::YUNSCALE; r1.y = bfhi(hv[u].z) + (a2.y + b2.y) * pg8::YUNSCALE; r1.z = bflo(hv[u].w) + (a3.x + b3.x) * pg8::YUNSCALE; r1.w = bfhi(hv[u].w) + (a3.y + b3.y) * pg8::YUNSCALE;
              o[0] = r0; o[1] = r1; } } } }
#endif
}

extern "C" void kernel_launch(void* const* d_in, const int* in_sizes, int n_in, void* d_out, int out_size, void* d_ws, size_t ws_size, hipStream_t stream) {
    static int grid = 0;
    if (grid == 0) {
        if (n_in != 21 || in_sizes[0] != S_ * DM || out_size != S_ * DM || ws_size < WS_END) { fprintf(stderr, "kernel_launch: unexpected shapes (n_in %d, in0 %d, out %d, ws %zu); nothing launched\n", n_in, n_in > 0 ? in_sizes[0] : -1, out_size, ws_size); grid = -1; return; }
        int dev = 0, cus = 0, per_cu = 0;
        if (hipGetDevice(&dev) != hipSuccess || hipDeviceGetAttribute(&cus, hipDeviceAttributeMultiprocessorCount, dev) != hipSuccess) { grid = -1; return; }
        if (hipFuncSetAttribute((const void*)hymba_fwd, hipFuncAttributeMaxDynamicSharedMemorySize, LDS_BYTES) != hipSuccess) { fprintf(stderr, "kernel_launch: hipFuncSetAttribute failed\n"); grid = -1; return; }
        if (hipOccupancyMaxActiveBlocksPerMultiprocessor(&per_cu, (const void*)hymba_fwd, NTHREADS, LDS_BYTES) != hipSuccess || per_cu < 1) { fprintf(stderr, "kernel_launch: occupancy query says %d blocks per CU\n", per_cu); (void)hipGetLastError(); grid = -1; return; }
        if (cus * UTAB_UNITS < 1280) { fprintf(stderr, "kernel_launch: %d CUs: more than %d GEMM units per workgroup; nothing launched\n", cus, UTAB_UNITS); grid = -1; return; }
        grid = cus;
    }
    if (grid < 0) return;
    (void)hipMemsetAsync((char*)d_ws + WS_CTL, 0, CTL_ZERO_BYTES, stream);
    Args a{};
    for (int i = 0; i < 21; ++i) a.in[i] = (const float*)d_in[i];
    a.out = (float*)d_out; a.ws = (unsigned char*)d_ws;
    hipLaunchKernelGGL(hymba_fwd, dim3(grid), dim3(NTHREADS), LDS_BYTES, stream, a);
}
```

```cpp
#include <hip/hip_runtime.h>
#include <cstdio>
#include <cstdint>

#ifndef MK_STAGE
#define MK_STAGE 3
#endif

constexpr int S_ = 16384, DM = 2048;
constexpr int PROJ_LD = 4864;
constexpr int C_AQ = 0, C_AK = 1024, C_AV = 1280, C_GQ = 1536, C_GK = 2048, C_GV = 2560, C_GR = 3584, C_LRF = 4608, C_LRB = 4624, IN_W = 4640;
constexpr float EPS_ = 1e-6f;
constexpr int NE = 32, DFF = 1024;
constexpr int P_XS = 2048 + 128, P_HID = 1024 + 128;
constexpr int MAX_TILES = 160, MAX_SLOTS = MAX_TILES * 256;

__device__ __forceinline__ int opaque_tid() { int t = threadIdx.x; asm volatile("" : "+v"(t)); return t; }
namespace pg8 {
#define PG8_LAS __attribute__((address_space(3)))
typedef unsigned short bf16_t;
typedef short bf16x8 __attribute__((ext_vector_type(8)));
typedef float f32x4 __attribute__((ext_vector_type(4)));
typedef unsigned u32x4 __attribute__((ext_vector_type(4)));
constexpr int BM = 256, BK = 64, HALF = 128, HTB = HALF * BK * 2, STAGE_BYTES = 8 * HTB, NXCD = 8, WGM = 8;

__host__ __device__ __forceinline__ int lds_byte(int r, int c) { const int st = (r >> 4) * 2 + (c >> 5), rr = r & 15, cc = c & 31, ob = rr * 64 + cc * 2; return st * 1024 + (ob ^ (((ob >> 9) & 1) << 5)); }
__host__ __device__ __forceinline__ void stage_rc(int b, int& R, int& C) { const int st = b / 1024, sb = b % 1024, swz = sb ^ (((sb >> 9) & 1) << 5); R = (st >> 1) * 16 + swz / 64; C = (st & 1) * 32 + (swz % 64) / 2; }
__host__ __device__ __forceinline__ int perm32(int rho) { const int n = rho >> 4, i = rho & 15; return 8 * (i >> 2) + 4 * n + (i & 3); }

typedef int v4i_q __attribute__((ext_vector_type(4)));
struct Unit { int pm, pn, pb; };
struct Gemm { const void* A; const void* Bt; int Kb; int pa, pb, ka, kb; size_t ta, tb; };

struct StaticOrder {
    int nM, nN, nwg, G, c;
    __device__ void init(int M, int N, int G_, int c_) { nM = M / BM; nN = N / BM; nwg = nM * nN; G = G_; c = c_; }
    __device__ bool next(int i, Unit& u) const {
        const long L = (long)i * G + c; if (L >= nwg) return false;
        int wgid = (int)L; { const int q = nwg / NXCD, r = nwg % NXCD, xcd = wgid % NXCD, off = wgid / NXCD; wgid = (xcd < r ? xcd * (q + 1) : r * (q + 1) + (xcd - r) * q) + off; }
        const int nig = WGM * nN, gid = wgid / nig, fm = gid * WGM, gsz = (nM - fm) < WGM ? (nM - fm) : WGM;
        u.pm = fm + ((wgid % nig) % gsz); u.pn = (wgid % nig) / gsz; u.pb = u.pn; return true;
    }
};
struct MoeOrder {
    int nM, nN, nwg, G, c; const PG8_LAS int* tile_e; const PG8_LAS int* tokl;
    __device__ void init(int nM_, int nN_, int G_, int c_, const PG8_LAS int* te, const PG8_LAS int* tl = nullptr) { nM = nM_; nN = nN_; nwg = nM * nN; G = G_; c = c_; tile_e = te; tokl = tl; }
    __device__ bool next(int i, Unit& u) const {
        const long L = (long)i * G + c; if (L >= nwg) return false;
        int wgid = (int)L; { const int q = nwg / NXCD, r = nwg % NXCD, xcd = wgid % NXCD, off = wgid / NXCD; wgid = (xcd < r ? xcd * (q + 1) : r * (q + 1) + (xcd - r) * q) + off; }
        const int nig = WGM * nN, gid = wgid / nig, fm = gid * WGM, gsz = (nM - fm) < WGM ? (nM - fm) : WGM;
        u.pm = fm + ((wgid % nig) % gsz); u.pn = (wgid % nig) / gsz; u.pb = tile_e[u.pm] * nN + u.pn; return true;
    }
};

__device__ __forceinline__ unsigned cvt_pk_bf16(float lo, float hi) { unsigned r; asm volatile("v_cvt_pk_bf16_f32 %0, %1, %2" : "=v"(r) : "v"(lo), "v"(hi)); return r; }

struct EpiBf16Q {
    static constexpr bool PERM = true;
    bf16_t* O; int ldc; const float* sa; const float* cmax;
    __device__ __forceinline__ void operator()(const f32x4 (&acc)[2][2][4][2], const Unit& u, int wr, int wc, int fr, int fq) const {
        const int row0 = u.pm * BM + wr * 64 + fr, col0 = u.pn * BM + wc * 32 + 8 * fq;
        f32x4 cs[2][2];
#pragma unroll
        for (int bj = 0; bj < 2; ++bj)
#pragma unroll
            for (int n = 0; n < 2; ++n) cs[bj][n] = *(const f32x4*)(cmax + col0 + bj * HALF + 4 * n) * (1.f / 127.f);
        float sav[2][4];
#pragma unroll
        for (int ai = 0; ai < 2; ++ai)
#pragma unroll
            for (int m = 0; m < 4; ++m) sav[ai][m] = sa[row0 + ai * HALF + m * 16];
#pragma unroll
        for (int ai = 0; ai < 2; ++ai)
#pragma unroll
            for (int m = 0; m < 4; ++m) { const int row = row0 + ai * HALF + m * 16; const float s = sav[ai][m]; bf16_t* rowp = O + (size_t)row * ldc + col0;
#pragma unroll
                for (int bj = 0; bj < 2; ++bj) { const v4i_q i0 = __builtin_bit_cast(v4i_q, acc[ai][bj][m][0]), i1 = __builtin_bit_cast(v4i_q, acc[ai][bj][m][1]);
                    const f32x4 v0 = __builtin_convertvector(i0, f32x4) * cs[bj][0] * s, v1 = __builtin_convertvector(i1, f32x4) * cs[bj][1] * s;
                    u32x4 w; w.x = cvt_pk_bf16(v0[0], v0[1]); w.y = cvt_pk_bf16(v0[2], v0[3]); w.z = cvt_pk_bf16(v1[0], v1[1]); w.w = cvt_pk_bf16(v1[2], v1[3]);
                    *(u32x4*)(rowp + bj * HALF) = w; } }
    }
};
struct EpiResBf16Q {
    static constexpr bool PERM = true;
    bf16_t* H; const float* R; int ldc; const float* sa; const float* cmax;
    __device__ __forceinline__ void operator()(const f32x4 (&acc)[2][2][4][2], const Unit& u, int wr, int wc, int fr, int fq) const {
        const int row0 = u.pm * BM + wr * 64 + fr, col0 = u.pn * BM + wc * 32 + 8 * fq;
        f32x4 cs[2][2];
#pragma unroll
        for (int bj = 0; bj < 2; ++bj)
#pragma unroll
            for (int n = 0; n < 2; ++n) cs[bj][n] = *(const f32x4*)(cmax + col0 + bj * HALF + 4 * n) * (1.f / 127.f);
        float sav[2][4];
#pragma unroll
        for (int ai = 0; ai < 2; ++ai)
#pragma unroll
            for (int m = 0; m < 4; ++m) sav[ai][m] = sa[row0 + ai * HALF + m * 16];
#pragma unroll
        for (int ai = 0; ai < 2; ++ai)
#pragma unroll
            for (int m = 0; m < 4; ++m) { const int row = row0 + ai * HALF + m * 16; const float s = sav[ai][m]; const size_t ro = (size_t)row * ldc + col0;
#pragma unroll
                for (int bj = 0; bj < 2; ++bj) { const f32x4 r0 = __builtin_nontemporal_load((const f32x4*)(R + ro + bj * HALF)), r1 = __builtin_nontemporal_load((const f32x4*)(R + ro + bj * HALF + 4));
                    const v4i_q i0 = __builtin_bit_cast(v4i_q, acc[ai][bj][m][0]), i1 = __builtin_bit_cast(v4i_q, acc[ai][bj][m][1]);
                    const f32x4 v0 = __builtin_convertvector(i0, f32x4) * cs[bj][0] * s + r0, v1 = __builtin_convertvector(i1, f32x4) * cs[bj][1] * s + r1;
                    u32x4 w; w.x = cvt_pk_bf16(v0[0], v0[1]); w.y = cvt_pk_bf16(v0[2], v0[3]); w.z = cvt_pk_bf16(v1[0], v1[1]); w.w = cvt_pk_bf16(v1[2], v1[3]);
                    *(u32x4*)(H + ro + bj * HALF) = w; } }
    }
};
__device__ __forceinline__ float silu_f(float g) { return g * __builtin_amdgcn_rcpf(1.f + __builtin_amdgcn_exp2f(-1.4426950408889634f * g)); }
__device__ __forceinline__ unsigned pk4_fp8(float a, float b, float c, float d) { int w = 0; w = __builtin_amdgcn_cvt_pk_fp8_f32(a, b, w, false); w = __builtin_amdgcn_cvt_pk_fp8_f32(c, d, w, true); return (unsigned)w; }
constexpr float WSCALE = 64.f, WUNSCALE = 1.f / 64.f;
struct EpiSwiGLU {
    static constexpr bool PERM = true;
    unsigned char* H; const float* rs;
    __device__ __forceinline__ void operator()(const f32x4 (&acc)[2][2][4][2], const Unit& u, int wr, int wc, int fr, int fq) const {
        const int row0 = u.pm * BM + wr * 64 + fr, col0 = u.pn * HALF + wc * 32 + 8 * fq;
        float rsv[2][4];
#pragma unroll
        for (int ai = 0; ai < 2; ++ai)
#pragma unroll
            for (int m = 0; m < 4; ++m) rsv[ai][m] = rs[row0 + ai * HALF + m * 16];
#pragma unroll
        for (int ai = 0; ai < 2; ++ai)
#pragma unroll
            for (int m = 0; m < 4; ++m) { const int row = row0 + ai * HALF + m * 16; const float r = rsv[ai][m] * WUNSCALE;
                float h[8];
#pragma unroll
                for (int n = 0; n < 2; ++n)
#pragma unroll
                    for (int e = 0; e < 4; ++e) h[n * 4 + e] = silu_f(acc[ai][0][m][n][e] * r) * (acc[ai][1][m][n][e] * r);
                unsigned w0 = pk4_fp8(h[0], h[1], h[2], h[3]), w1 = pk4_fp8(h[4], h[5], h[6], h[7]);
                typedef unsigned u32x2_t __attribute__((ext_vector_type(2)));
                *(u32x2_t*)(H + (size_t)u.pm * (256 * DFF) + (size_t)u.pn * 32768 + (row & 255) * 128 + wc * 32 + 8 * fq) = (u32x2_t){w0, w1}; }
    }
};
constexpr float YSCALE = 16.f, YUNSCALE = 1.f / 16.f;
struct EpiMoeOut {
    static constexpr bool PERM = true;
    unsigned char* Y; const int* dst; const float* w;
    __device__ __forceinline__ void operator()(const f32x4 (&acc)[2][2][4][2], const Unit& u, int wr, int wc, int fr, int fq) const {
        const int row0 = u.pm * BM + wr * 64 + fr, col0 = u.pn * BM + wc * 64 + 16 * fq;
        int dv[2][4]; float wv[2][4];
#pragma unroll
        for (int ai = 0; ai < 2; ++ai)
#pragma unroll
            for (int m = 0; m < 4; ++m) { dv[ai][m] = dst[row0 + ai * HALF + m * 16]; wv[ai][m] = w[row0 + ai * HALF + m * 16]; }
#pragma unroll
        for (int ai = 0; ai < 2; ++ai)
#pragma unroll
            for (int m = 0; m < 4; ++m) { const int d = dv[ai][m]; const float ww = wv[ai][m] * (WUNSCALE * YSCALE);
                if (d >= 0) { const f32x4 v0 = acc[ai][0][m][0] * ww, v1 = acc[ai][0][m][1] * ww, v2 = acc[ai][1][m][0] * ww, v3 = acc[ai][1][m][1] * ww;
                    *(u32x4*)(Y + (size_t)d * DM + col0) = (u32x4){pk4_fp8(v0[0], v0[1], v0[2], v0[3]), pk4_fp8(v1[0], v1[1], v1[2], v1[3]), pk4_fp8(v2[0], v2[1], v2[2], v2[3]), pk4_fp8(v3[0], v3[1], v3[2], v3[3])}; } }
    }
};

typedef int v4i_t __attribute__((ext_vector_type(4)));
typedef int v8i_t __attribute__((ext_vector_type(8)));
template <class Epi, class Sched, int MODE = 0, bool GATHER = false>
__device__ __forceinline__ void gemm_phase(PG8_LAS unsigned char* lds, const Gemm g, const Sched& S, const Epi& E) {
    const int tid = opaque_tid(), wid = __builtin_amdgcn_readfirstlane(tid >> 6), lane = tid & 63, wr = wid >> 2, wc = wid & 3, fr = lane & 15, fq = lane >> 4;
    const int Kb = g.Kb, nt = Kb / (BK * 2);
    unsigned voffA[2], voffB[2];
#pragma unroll
    for (int i = 0; i < 2; ++i) { int R, C; stage_rc(tid * 16 + i * 8192, R, C); const int Rb = Epi::PERM ? ((R & ~31) + perm32(R & 31)) : R;
        voffA[i] = (unsigned)(R * g.pa + C * 2); voffB[i] = (unsigned)(Rb * g.pb + C * 2); }
    unsigned vA[2][2] = {{0u, 0u}, {0u, 0u}}, vN[2][2] = {{0u, 0u}, {0u, 0u}}; int gR[2] = {0, 0}; unsigned gC[2] = {0u, 0u};
    if constexpr (GATHER) {
#pragma unroll
        for (int i = 0; i < 2; ++i) { int R, C; stage_rc(tid * 16 + i * 8192, R, C); gR[i] = R; gC[i] = (unsigned)(C * 2); }
#pragma unroll
        for (int h = 0; h < 2; ++h)
#pragma unroll
            for (int i = 0; i < 2; ++i) vA[h][i] = (unsigned)S.tokl[gR[i] + HALF * h] * (unsigned)g.pa + gC[i]; }
    const size_t kstepA = (size_t)g.ka, kstepB = (size_t)g.kb;
    const size_t hstepA = (size_t)HALF * g.pa, hstepB = (size_t)HALF * g.pb;
    const size_t tstepA = g.ta, tstepB = g.tb;
    const unsigned ldsw = (unsigned)wid * 1024u;
    const int aoff = lds_byte(wr * 64 + fr, fq * 8), boff = lds_byte(wc * 32 + fr, fq * 8);
#define PG8_SA(b, h) (((b) * 2 + (h)) * HTB)
#define PG8_SB(b, h) ((4 + (b) * 2 + (h)) * HTB)
#define PG8_STAGE(bufoff, gbase, voff) do { _Pragma("unroll") for (int _i = 0; _i < 2; ++_i) \
        __builtin_amdgcn_global_load_lds((const unsigned*)((const char*)(gbase) + (voff)[_i]), (PG8_LAS unsigned*)(lds + (bufoff) + ldsw + _i * 8192), 16, 0, 0); } while (0)
#define PG8_STAGE_A(bufoff, kptr, h, nx) do { if constexpr (GATHER) { _Pragma("unroll") for (int _i = 0; _i < 2; ++_i) \
        __builtin_amdgcn_global_load_lds((const unsigned*)((const char*)(kptr) + ((nx) ? vN[h][_i] : vA[h][_i])), (PG8_LAS unsigned*)(lds + (bufoff) + ldsw + _i * 8192), 16, 0, 0); } \
        else PG8_STAGE(bufoff, (kptr) + ((h) ? hstepA : (size_t)0), voffA); } while (0)
#define PG8_LD8(p) __builtin_shufflevector(*(const PG8_LAS v4i_t*)(p), *(const PG8_LAS v4i_t*)((p) + 1024), 0, 1, 2, 3, 4, 5, 6, 7)
#define PG8_LDA(dst, b, h) do { _Pragma("unroll") for (int m = 0; m < 4; ++m) dst[m] = PG8_LD8(lds + PG8_SA(b, h) + aoff + m * 2048); } while (0)
#define PG8_LDB(dst, b, h) do { _Pragma("unroll") for (int n = 0; n < 2; ++n) dst[n] = PG8_LD8(lds + PG8_SB(b, h) + boff + n * 2048); } while (0)
#define PG8_LO(v) __builtin_bit_cast(bf16x8, __builtin_shufflevector(v, v, 0, 1, 2, 3))
#define PG8_HI(v) __builtin_bit_cast(bf16x8, __builtin_shufflevector(v, v, 4, 5, 6, 7))
#define PG8_LO4(v) __builtin_shufflevector(v, v, 0, 1, 2, 3)
#define PG8_HI4(v) __builtin_shufflevector(v, v, 4, 5, 6, 7)
#define PG8_MMA(ai, bj, At, Bt) do { __builtin_amdgcn_s_setprio(1); _Pragma("unroll") for (int m = 0; m < 4; ++m) _Pragma("unroll") for (int n = 0; n < 2; ++n) { \
        if constexpr (MODE == 1) { asm volatile("v_mfma_scale_f32_16x16x128_f8f6f4 %0, %1, %2, %0, %3, %3 op_sel_hi:[0,0,0]" : "+v"(acc[ai][bj][m][n]) : "v"(Bt[n]), "v"(At[m]), "v"(sc127)); } \
        else if constexpr (MODE == 2) { v4i_t c_ = __builtin_bit_cast(v4i_t, acc[ai][bj][m][n]); c_ = __builtin_amdgcn_mfma_i32_16x16x64_i8(PG8_LO4(Bt[n]), PG8_LO4(At[m]), c_, 0, 0, 0); \
               c_ = __builtin_amdgcn_mfma_i32_16x16x64_i8(PG8_HI4(Bt[n]), PG8_HI4(At[m]), c_, 0, 0, 0); acc[ai][bj][m][n] = __builtin_bit_cast(f32x4, c_); } \
        else { acc[ai][bj][m][n] = __builtin_amdgcn_mfma_f32_16x16x32_bf16(PG8_LO(Bt[n]), PG8_LO(At[m]), acc[ai][bj][m][n], 0, 0, 0); \
               acc[ai][bj][m][n] = __builtin_amdgcn_mfma_f32_16x16x32_bf16(PG8_HI(Bt[n]), PG8_HI(At[m]), acc[ai][bj][m][n], 0, 0, 0); } } \
        __builtin_amdgcn_s_setprio(0); } while (0)
#define PG8_WAIT_V(n) asm volatile("s_waitcnt vmcnt(" #n ")" ::: "memory")
#define PG8_WAIT_L(n) asm volatile("s_waitcnt lgkmcnt(" #n ")" ::: "memory")
#define PG8_BAR __builtin_amdgcn_s_barrier()
#define PG8_SCHED __builtin_amdgcn_sched_barrier(0)
    Unit cur, nxt; int ui = 0;
    if (!S.next(0, cur)) return;
    int sc127 = 127; asm volatile("" : "+v"(sc127));
    f32x4 acc[2][2][4][2];
#pragma unroll
    for (int a = 0; a < 2; ++a)
#pragma unroll
        for (int b = 0; b < 2; ++b)
#pragma unroll
            for (int m = 0; m < 4; ++m)
#pragma unroll
                for (int n = 0; n < 2; ++n) acc[a][b][m][n] = (f32x4){0.f, 0.f, 0.f, 0.f};
    v8i_t At[4], B0[2], B1[2];
    const char* cA = (const char*)g.A + (GATHER ? (size_t)0 : (size_t)cur.pm * tstepA); const char* cB = (const char*)g.Bt + (size_t)cur.pb * tstepB;
    PG8_STAGE(PG8_SB(0, 0), cB, voffB); PG8_STAGE(PG8_SB(0, 1), cB + hstepB, voffB); PG8_STAGE_A(PG8_SA(0, 0), cA, 0, false); PG8_STAGE_A(PG8_SA(0, 1), cA, 1, false);
    if (wr == 1) PG8_BAR;
    PG8_WAIT_V(2); PG8_BAR;
    PG8_STAGE(PG8_SB(1, 0), cB + kstepB, voffB); PG8_STAGE_A(PG8_SA(1, 0), cA + kstepA, 0, false); PG8_STAGE(PG8_SB(1, 1), cB + hstepB + kstepB, voffB);
    PG8_WAIT_V(6); PG8_BAR;
    for (;;) {
        const bool has_next = S.next(ui + 1, nxt);
        const char* nA = (has_next && !GATHER) ? (const char*)g.A + (size_t)nxt.pm * tstepA : cA; const char* nB = has_next ? (const char*)g.Bt + (size_t)nxt.pb * tstepB : cB;
        if constexpr (GATHER) { const int ub = has_next ? (ui + 1) * 256 : ui * 256;
#pragma unroll
            for (int h = 0; h < 2; ++h)
#pragma unroll
                for (int i = 0; i < 2; ++i) vN[h][i] = (unsigned)S.tokl[ub + gR[i] + HALF * h] * (unsigned)g.pa + gC[i]; }
        for (int t = 0; t < nt; t += 2) {
            const bool last = (t == nt - 2);
            const char* a1 = cA + (size_t)(t + 1) * kstepA;
            const char* a2 = last ? nA : cA + (size_t)(t + 2) * kstepA; const char* b2 = last ? nB : cB + (size_t)(t + 2) * kstepB;
            const char* a3 = a2 + kstepA; const char* b3 = b2 + kstepB;
            PG8_LDB(B0, 0, 0); PG8_LDB(B1, 0, 1); PG8_SCHED; PG8_LDA(At, 0, 0); PG8_STAGE_A(PG8_SA(1, 1), a1, 1, false);
            PG8_WAIT_V(8); PG8_WAIT_L(0); PG8_BAR; PG8_MMA(0, 0, At, B0); PG8_MMA(0, 1, At, B1); PG8_BAR; PG8_SCHED;
            PG8_LDA(At, 0, 1); PG8_STAGE(PG8_SB(0, 0), b2, voffB); PG8_STAGE(PG8_SB(0, 1), b2 + hstepB, voffB); PG8_STAGE_A(PG8_SA(0, 0), a2, 0, last);
            PG8_WAIT_V(8); PG8_WAIT_L(0); PG8_BAR; PG8_MMA(1, 0, At, B0); PG8_MMA(1, 1, At, B1); PG8_BAR; PG8_SCHED;
            PG8_LDB(B0, 1, 0); PG8_LDB(B1, 1, 1); PG8_SCHED; PG8_LDA(At, 1, 0); PG8_STAGE_A(PG8_SA(0, 1), a2, 1, last);
            PG8_WAIT_V(8); PG8_WAIT_L(0); PG8_BAR; PG8_MMA(0, 0, At, B0); PG8_MMA(0, 1, At, B1); PG8_BAR; PG8_SCHED;
            PG8_LDA(At, 1, 1); PG8_STAGE(PG8_SB(1, 0), b3, voffB); PG8_STAGE(PG8_SB(1, 1), b3 + hstepB, voffB); PG8_STAGE_A(PG8_SA(1, 0), a3, 0, last);
            PG8_WAIT_V(8); PG8_WAIT_L(0); PG8_BAR; PG8_MMA(1, 0, At, B0); PG8_MMA(1, 1, At, B1); PG8_BAR; PG8_SCHED;
        }
        if (wr == 0) PG8_BAR;
        if constexpr (MODE == 1) asm volatile("s_nop 15\n\ts_nop 15" ::: "memory");
        E(acc, cur, wr, wc, fr, fq);
        if constexpr (MODE == 1) asm volatile("s_nop 7" ::: "memory");
        if (!has_next) break;
#pragma unroll
        for (int a = 0; a < 2; ++a)
#pragma unroll
            for (int b = 0; b < 2; ++b)
#pragma unroll
                for (int m = 0; m < 4; ++m)
#pragma unroll
                    for (int n = 0; n < 2; ++n) acc[a][b][m][n] = (f32x4){0.f, 0.f, 0.f, 0.f};
        cur = nxt; cA = nA; cB = nB; ++ui;
        if constexpr (GATHER) { vA[0][0] = vN[0][0]; vA[0][1] = vN[0][1]; vA[1][0] = vN[1][0]; vA[1][1] = vN[1][1]; }
        if (wr == 1) PG8_BAR;
    }
    PG8_WAIT_V(0);
    PG8_BAR;
#undef PG8_SA
#undef PG8_SB
#undef PG8_STAGE
#undef PG8_STAGE_A
#undef PG8_LDA
#undef PG8_LDB
#undef PG8_LD8
#undef PG8_LO
#undef PG8_HI
#undef PG8_LO4
#undef PG8_HI4
#undef PG8_MMA
#undef PG8_WAIT_V
#undef PG8_WAIT_L
#undef PG8_BAR
#undef PG8_SCHED
}
}

constexpr int NWAVES = 8, NTHREADS = NWAVES * 64;
constexpr size_t MiB = 1u << 20;
constexpr size_t WS_CTL = 0, CTL_ZERO_BYTES = 1 * MiB;
constexpr size_t WS_COS = 1 * MiB, WS_SIN = 2 * MiB;
constexpr size_t WS_ASSQ = 3 * MiB;
constexpr size_t WS_TOKE = 4 * MiB, WS_TOKW = 5 * MiB, WS_TOKR = 6 * MiB;
constexpr size_t WS_CNT = 7 * MiB;
constexpr size_t WS_SDST = 8 * MiB, WS_SW = 9 * MiB, WS_SRS = 10 * MiB;
constexpr size_t WS_TILEE = 11 * MiB;
constexpr size_t WS_WR = 12 * MiB;
constexpr size_t WS_DECT = 14 * MiB;
constexpr size_t WS_DS = 16 * MiB;
constexpr size_t WS_WIN = 64 * MiB, WS_WOUT = 84 * MiB, WS_WGU = 92 * MiB, WS_WD = 348 * MiB;
constexpr size_t WS_XN = 476 * MiB;
constexpr size_t WS_PROJ = 540 * MiB;
constexpr size_t WS_ARAW = 692 * MiB;
constexpr size_t WS_MIX = 724 * MiB;
constexpr int XN2_P = 2176;
constexpr size_t WS_XN2 = 756 * MiB;
constexpr size_t WS_HID = 820 * MiB;
constexpr size_t WS_SIN_ST = 900 * MiB;
constexpr size_t WS_OF = 932 * MiB;
constexpr size_t WS_H = 476 * MiB;
constexpr size_t WS_XS = 540 * MiB;
constexpr size_t WS_Y = 640 * MiB;
constexpr size_t WS_END = 996 * MiB;
constexpr int CW_CMAX_IN = 16384, CW_CMAX_OUT = 16384 + 4864;
constexpr size_t WS_SAX = 15 * MiB, WS_SAM = 15 * MiB + 65536;
constexpr int CW_BAR = 4096;
constexpr int RING_BYTES = 131072, LDSCTL_OFF = RING_BYTES, MISC_OFF = LDSCTL_OFF + 320, TILEE_OFF = MISC_OFF + 128;
constexpr int LDS_BYTES = 147456;

#define GAS __attribute__((address_space(1)))
#define LAS __attribute__((address_space(3)))
typedef unsigned short bf16;
typedef float f32x4 __attribute__((ext_vector_type(4)));
typedef float f32x16 __attribute__((ext_vector_type(16)));
typedef short bf16x8 __attribute__((ext_vector_type(8)));
typedef short s16x4 __attribute__((ext_vector_type(4)));
typedef unsigned u32x4 __attribute__((ext_vector_type(4)));
typedef unsigned u32x2 __attribute__((ext_vector_type(2)));
#define LDS_WAIT() asm volatile("s_waitcnt lgkmcnt(0)" ::: "memory")
#define VM_WAIT() asm volatile("s_waitcnt vmcnt(0)" ::: "memory")
#define SBAR() __builtin_amdgcn_sched_barrier(0)
__device__ __forceinline__ unsigned f2bf(float f) { unsigned u = __builtin_bit_cast(unsigned, f); return (u + 0x7fffu + ((u >> 16) & 1u)) >> 16; }
__device__ __forceinline__ unsigned pk2(float lo, float hi) { return f2bf(lo) | (f2bf(hi) << 16); }
__device__ __forceinline__ float bflo(unsigned w) { return __builtin_bit_cast(float, w << 16); }
__device__ __forceinline__ float bfhi(unsigned w) { return __builtin_bit_cast(float, w & 0xffff0000u); }
#define WV_DPP(v, ctrl, rmask) __builtin_bit_cast(float, __builtin_amdgcn_update_dpp(0, __builtin_bit_cast(int, v), ctrl, rmask, 0xF, false))
__device__ __forceinline__ float wave_max(float v) {
    v = fmaxf(v, WV_DPP(v, 0x111, 0xF)); v = fmaxf(v, WV_DPP(v, 0x112, 0xF)); v = fmaxf(v, WV_DPP(v, 0x114, 0xF)); v = fmaxf(v, WV_DPP(v, 0x118, 0xF));
    v = fmaxf(v, WV_DPP(v, 0x142, 0xA)); v = fmaxf(v, WV_DPP(v, 0x143, 0xC));
    return __builtin_bit_cast(float, __builtin_amdgcn_readlane(__builtin_bit_cast(int, v), 63));
}
__device__ __forceinline__ float wave_sum(float v) {
    v += WV_DPP(v, 0x111, 0xF); v += WV_DPP(v, 0x112, 0xF); v += WV_DPP(v, 0x114, 0xF); v += WV_DPP(v, 0x118, 0xF);
    v += WV_DPP(v, 0x142, 0xA); v += WV_DPP(v, 0x143, 0xC);
    return __builtin_bit_cast(float, __builtin_amdgcn_readlane(__builtin_bit_cast(int, v), 63));
}

#define XB_TMO      128
#define XB_XCNT(j)  (256  + 64 * (j))
#define XB_XSUB(j)  (1280 + 64 * (j))
#define XB_XGEN(j)  (2304 + 64 * (j))
#define XB_TOP      3328
#define XB_TOPGEN   3392
#define XCD_BAR_WORDS 3456
#define XB_SPIN_CAP (1u << 18)
__device__ __forceinline__ unsigned xb_ld(unsigned* p)              { return __hip_atomic_load(p, __ATOMIC_RELAXED, __HIP_MEMORY_SCOPE_AGENT); }
__device__ __forceinline__ unsigned xb_add(unsigned* p, unsigned v) { return __hip_atomic_fetch_add(p, v, __ATOMIC_RELAXED, __HIP_MEMORY_SCOPE_AGENT); }
__device__ __forceinline__ unsigned xb_xcc_id() { return (unsigned)__builtin_amdgcn_s_getreg((3 << 11) | 20) & 0xFu; }
#define XB_SPIN(cond, bar) do { unsigned _sp = 0; while (cond) { __builtin_amdgcn_s_sleep(1); \
    if ((++_sp & 255u) == 0u) { if (xb_ld(&(bar)[XB_TMO])) break; if (_sp > XB_SPIN_CAP) { atomicAdd(&(bar)[XB_TMO], 1u); break; } } } } while (0)
struct XcdBarrier { unsigned* bar; unsigned x; volatile LAS unsigned* st; };
__device__ __forceinline__ XcdBarrier xcd_barrier_post(unsigned* bar, volatile LAS unsigned* st) {
    XcdBarrier b; b.bar = bar; b.x = xb_xcc_id(); b.st = st;
    if (threadIdx.x == 0) (void)xb_add(&bar[XB_XCNT(b.x)], 1u);
    return b;
}
__device__ __forceinline__ void xcd_barrier_complete(unsigned* bar, unsigned x, unsigned& nloc, unsigned& nx) {
    const unsigned G = gridDim.x * gridDim.y * gridDim.z;
    unsigned sum, cnt, mine, sp = 0u;
    for (;;) {
        sum = 0u; cnt = 0u; mine = 0u;
#pragma unroll
        for (unsigned j = 0; j < 16; ++j) { const unsigned c = xb_ld(&bar[XB_XCNT(j)]); sum += c; cnt += (c > 0u) ? 1u : 0u; mine = (j == x) ? c : mine; }
        if (sum == G) break;
        __builtin_amdgcn_s_sleep(1);
        if ((++sp & 255u) == 0u) { if (xb_ld(&bar[XB_TMO])) break; if (sp > XB_SPIN_CAP) { atomicAdd(&bar[XB_TMO], 1u); break; } }
    }
    nloc = mine > 0u ? mine : 1u; nx = cnt > 0u ? cnt : 1u;
}
__device__ __forceinline__ void xcd_barrier(const XcdBarrier& b) {
    asm volatile("s_waitcnt vmcnt(0)" ::: "memory");
    __syncthreads();
    if (threadIdx.x == 0) {
        unsigned* bar = b.bar;
        __builtin_amdgcn_s_waitcnt(0);
        unsigned nloc = b.st[0], nx = b.st[1];
        if (nloc == 0u) { xcd_barrier_complete(bar, b.x, nloc, nx); b.st[0] = nloc; b.st[1] = nx; }
        const unsigned old = xb_add(&bar[XB_XSUB(b.x)], 1u);
        const unsigned gen = old / nloc;
        if (old + 1u == (gen + 1u) * nloc) {
            __builtin_amdgcn_fence(__ATOMIC_RELEASE, "agent");
            asm volatile("s_waitcnt vmcnt(0)" ::: "memory");
            const unsigned og = xb_add(&bar[XB_TOP], 1u);
            const unsigned tg = og / nx;
            if (og + 1u == (tg + 1u) * nx) xb_add(&bar[XB_TOPGEN], 1u);
            else XB_SPIN(xb_ld(&bar[XB_TOPGEN]) == tg, bar);
            __builtin_amdgcn_fence(__ATOMIC_ACQUIRE, "agent");
            xb_add(&bar[XB_XGEN(b.x)], 1u);
            asm volatile("s_waitcnt vmcnt(0)" ::: "memory");
        } else {
            XB_SPIN(xb_ld(&bar[XB_XGEN(b.x)]) == gen, bar);
            __builtin_amdgcn_fence(__ATOMIC_ACQUIRE, "agent");
            asm volatile("s_waitcnt vmcnt(0)" ::: "memory");
        }
    }
    __syncthreads();
}

struct Args { const float* in[21]; float* out; unsigned char* ws; };
enum { I_X = 0, I_LN1, I_WIN, I_QNW, I_KNW, I_SINK, I_ANW, I_UPF, I_BF, I_UPB, I_BB, I_GNW, I_WOUT, I_LN2, I_WG, I_BG, I_WR, I_BR, I_WGE, I_WUE, I_WDE };

__device__ __forceinline__ unsigned pk4_i8(float a, float b, float c, float d) { const int i0 = __float2int_rn(a), i1 = __float2int_rn(b), i2 = __float2int_rn(c), i3 = __float2int_rn(d); return (unsigned)(i0 & 0xff) | ((unsigned)(i1 & 0xff) << 8) | ((unsigned)(i2 & 0xff) << 16) | ((unsigned)i3 << 24); }
struct TItem { const float* W; unsigned char* WT; const float* colmax; size_t dst_row0; int ldn, k0, n0, ldkb; float scale; };
__device__ __forceinline__ void titem_load(const TItem& t, f32x4 (&v)[16], int lane) {
    const int kr = lane >> 3, n4 = (lane & 7) * 4;
#pragma unroll
    for (int i = 0; i < 16; ++i) v[i] = __builtin_nontemporal_load((const GAS f32x4*)(t.W + (size_t)(t.k0 + 8 * i + kr) * t.ldn + t.n0 + n4));
}
__device__ __forceinline__ void titem_store_i8(const TItem& t, const f32x4 (&v)[16], LAS float* scr, int lane, const float (&scale_n)[4]) {
    const int kr = lane >> 3, q = lane & 7, nj = lane >> 3, p = lane & 7;
#pragma unroll
    for (int i = 0; i < 16; ++i) *(LAS f32x4*)(scr + (8 * i + kr) * 32 + 4 * (q ^ (i >> 1))) = v[i];
    LDS_WAIT(); asm volatile("" ::: "memory");
#pragma unroll
    for (int itr = 0; itr < 4; ++itr) { const int n = 8 * itr + nj; const LAS float* s = scr + (2 * p) * 256 + 4 * ((n >> 2) ^ p) + (n & 3); float f[16]; const float scale = scale_n[itr];
#pragma unroll
        for (int i = 0; i < 16; ++i) f[i] = s[(i >> 3) * 256 + (i & 7) * 32] * scale;
        u32x4 o; o.x = pk4_i8(f[0], f[1], f[2], f[3]); o.y = pk4_i8(f[4], f[5], f[6], f[7]); o.z = pk4_i8(f[8], f[9], f[10], f[11]); o.w = pk4_i8(f[12], f[13], f[14], f[15]);
        const size_t dr = t.dst_row0 + n;
        *(GAS u32x4*)(t.WT + dr * (size_t)t.ldkb + t.k0 + 16 * p) = o; }
    LDS_WAIT(); asm volatile("" ::: "memory");
}
template <int CLS> __device__ __forceinline__ TItem titem_make(const Args& a, int r) {
    unsigned char* ws = a.ws; TItem t; t.colmax = nullptr; t.scale = pg8::WSCALE;
    if (CLS == 0) { const int up = r >= 32 * 512; if (up) r -= 32 * 512; const int e = r >> 9, rr = r & 511, kb = rr >> 5, nb = rr & 31, n0 = nb * 32;
        t.W = a.in[up ? I_WUE : I_WGE] + (size_t)e * DM * DFF; t.ldn = DFF; t.k0 = kb * 128; t.n0 = n0; t.WT = ws + WS_WGU + (size_t)e * 2048 * DM; t.dst_row0 = (size_t)((n0 >> 7) * 256 + (n0 & 127) + up * 128); t.ldkb = -DM; }
    else if (CLS == 1) { const int e = r >> 9, rr = r & 511, kb = rr >> 6, nb = rr & 63;
        t.W = a.in[I_WDE] + (size_t)e * DFF * DM; t.ldn = DM; t.k0 = kb * 128; t.n0 = nb * 32; t.WT = ws + WS_WD + (size_t)e * DM * DFF; t.dst_row0 = (size_t)nb * 32; t.ldkb = -DFF; }
    else { t.scale = 1.f;
        if (r < 16 * 145) { const int kb = r / 145, nb = r % 145; t.W = a.in[I_WIN]; t.ldn = IN_W; t.k0 = kb * 128; t.n0 = nb * 32; t.WT = ws + WS_WIN; t.dst_row0 = (size_t)nb * 32; t.ldkb = DM; t.colmax = (const float*)(ws + WS_CTL) + CW_CMAX_IN; }
        else { r -= 16 * 145; const int kb = r >> 6, nb = r & 63; t.W = a.in[I_WOUT]; t.ldn = DM; t.k0 = kb * 128; t.n0 = nb * 32; t.WT = ws + WS_WOUT; t.dst_row0 = (size_t)nb * 32; t.ldkb = DM; t.colmax = (const float*)(ws + WS_CTL) + CW_CMAX_OUT; } }
    return t;
}
template <int CLS> __device__ __forceinline__ void titem_run(const Args& a, int it0, int nitems, int gw, int NGW, LAS float* scr, int lane) {
    static_assert(CLS != 2, "the int8 items go through p0_strip");
    const int kr = lane >> 3, q = lane & 7, nj = lane >> 3, p = lane & 7;
#pragma unroll 1
    for (int it = gw; it < nitems; it += NGW) { const TItem t = titem_make<CLS>(a, it0 + it);
        const float* src = t.W + (size_t)(t.k0 + kr) * t.ldn + t.n0;
#pragma unroll
        for (int i = 0; i < 16; ++i) __builtin_amdgcn_global_load_lds((const unsigned*)(src + (size_t)(8 * i) * t.ldn + 4 * (q ^ (i >> 1))), (LAS unsigned*)(scr + (8 * i) * 32), 16, 0, 2);
        asm volatile("s_waitcnt vmcnt(0)" ::: "memory");
        const float scale = t.scale;
#pragma unroll
        for (int itr = 0; itr < 4; ++itr) { const int n = 8 * itr + nj; const LAS float* s = scr + (2 * p) * 256 + 4 * ((n >> 2) ^ p) + (n & 3); float f[16];
#pragma unroll
            for (int i = 0; i < 16; ++i) f[i] = s[(i >> 3) * 256 + (i & 7) * 32] * scale;
            u32x4 o; o.x = pg8::pk4_fp8(f[0], f[1], f[2], f[3]); o.y = pg8::pk4_fp8(f[4], f[5], f[6], f[7]); o.z = pg8::pk4_fp8(f[8], f[9], f[10], f[11]); o.w = pg8::pk4_fp8(f[12], f[13], f[14], f[15]);
            size_t dr = t.dst_row0 + n;
            if (CLS == 1) { const int cl0 = (int)(t.dst_row0 & 255) + 8 * itr; dr = (t.dst_row0 & ~(size_t)255) + 128 * ((cl0 >> 3) & 1) + 32 * (cl0 >> 6) + 8 * ((cl0 >> 4) & 3) + nj; }
            unsigned char* dp = t.ldkb > 0 ? t.WT + dr * (size_t)t.ldkb + t.k0 + 16 * p : t.WT + (dr >> 8) * (size_t)(256 * -t.ldkb) + (size_t)(t.k0 >> 7) * 32768 + (dr & 255) * 128 + 16 * p;
            __builtin_nontemporal_store(o, (GAS u32x4*)dp); }
        LDS_WAIT(); asm volatile("" ::: "memory"); }
}
__device__ __forceinline__ void p0_strip(const Args& a, int strip, LAS float* scr, LAS float* cmw, int wave, int lane) {
    unsigned char* ws = a.ws; const bool o = strip >= 145; const int nb = o ? strip - 145 : strip, ldn = o ? DM : IN_W, n0 = nb * 32;
    const float* W = a.in[o ? I_WOUT : I_WIN]; float* cm = (float*)(ws + WS_CTL) + (o ? CW_CMAX_OUT : CW_CMAX_IN);
    const int n4 = (lane & 7) * 4;
    TItem t0; t0.W = W; t0.ldn = ldn; t0.n0 = n0; t0.WT = ws + (o ? WS_WOUT : WS_WIN); t0.dst_row0 = (size_t)n0; t0.ldkb = DM; t0.colmax = nullptr; t0.scale = 1.f; t0.k0 = (2 * wave) * 128;
    TItem t1 = t0; t1.k0 = (2 * wave + 1) * 128;
    f32x4 v0[16], v1[16]; titem_load(t0, v0, lane); titem_load(t1, v1, lane);
    f32x4 m = {0.f, 0.f, 0.f, 0.f};
#pragma unroll
    for (int i = 0; i < 16; ++i) { m.x = fmaxf(m.x, fmaxf(fabsf(v0[i].x), fabsf(v1[i].x))); m.y = fmaxf(m.y, fmaxf(fabsf(v0[i].y), fabsf(v1[i].y))); m.z = fmaxf(m.z, fmaxf(fabsf(v0[i].z), fabsf(v1[i].z))); m.w = fmaxf(m.w, fmaxf(fabsf(v0[i].w), fabsf(v1[i].w))); }
#pragma unroll
    for (int s = 8; s < 64; s <<= 1) { m.x = fmaxf(m.x, __shfl_xor(m.x, s)); m.y = fmaxf(m.y, __shfl_xor(m.y, s)); m.z = fmaxf(m.z, __shfl_xor(m.z, s)); m.w = fmaxf(m.w, __shfl_xor(m.w, s)); }
    if (lane < 8) *(LAS f32x4*)(cmw + wave * 32 + n4) = m;
    __syncthreads();
    float cmn = 0.f;
#pragma unroll
    for (int w = 0; w < 8; ++w) cmn = fmaxf(cmn, cmw[w * 32 + (lane & 31)]);
    if (wave == 0 && lane < 32) cm[n0 + lane] = cmn;
    float scale_n[4];
#pragma unroll
    for (int itr = 0; itr < 4; ++itr) { const float c = __shfl(cmn, 8 * itr + (lane >> 3)); scale_n[itr] = c > 0.f ? 127.f / c : 0.f; }
    titem_store_i8(t0, v0, scr, lane, scale_n);
    titem_store_i8(t1, v1, scr, lane, scale_n);
    __syncthreads();
}
__device__ __forceinline__ void p0_prologue(const Args& a, LAS unsigned char* lds, int wave, int lane, int G) {
    unsigned char* ws = a.ws;
    LAS float* scr = (LAS float*)(lds + wave * 16384);
    const int gw = blockIdx.x * NWAVES + wave, NGW = G * NWAVES;
    const int gt = blockIdx.x * NTHREADS + threadIdx.x, NGT = G * NTHREADS;
    constexpr int NSTRIP_IN = 145;
    { LAS float* cmw = (LAS float*)(lds + TILEE_OFF + 1024);
      for (int s = blockIdx.x; s < NSTRIP_IN; s += G) p0_strip(a, s, scr, cmw, wave, lane); }
    { GAS u32x4* z = (GAS u32x4*)(ws + WS_WIN + (size_t)IN_W * DM); const int n16 = (PROJ_LD - IN_W) * DM / 16;
      for (int i = gt; i < n16; i += NGT) z[i] = (u32x4){0u, 0u, 0u, 0u}; }
    { bf16* wr = (bf16*)(ws + WS_WR);
      for (int i = gt; i < 64 * DM; i += NGT) { const int n = i >> 11, k = i & 2047; float v = 0.f;
          if (n < 4) v = a.in[I_WG][k * 4 + n]; else if (n < 36) v = a.in[I_WR][k * 32 + (n - 4)];
          wr[i] = (bf16)f2bf(v); } }
    { float* cs = (float*)(ws + WS_COS); float* sn = (float*)(ws + WS_SIN);
      for (int i = gt; i < S_ * 16; i += NGT) { const int pos = i >> 4, f = i & 15; double inv;
          switch (f) { case 0: inv = 1.0; break; case 1: inv = 0.4403666026717805; break; case 2: inv = 0.1939227447486858; break; case 3: inv = 0.08539710028576561; break;
              case 4: inv = 0.03760603093086394; break; case 5: inv = 0.016560440080994443; break; case 6: inv = 0.007292664737217109; break; case 7: inv = 0.0032114459947525913; break;
              case 8: inv = 0.0014142135623730955; break; case 9: inv = 0.0006227724219145962; break; case 10: inv = 0.00027424817567620724; break; case 11: inv = 0.00012076973741146502; break;
              case 12: inv = 5.318295896944988e-05; break; case 13: inv = 2.3419998961409345e-05; break; case 14: inv = 1.0313385377212461e-05; break; default: inv = 4.541670480607871e-06; break; }
          const double rev = (double)pos * inv * 0.15915494309189535; const float fr = (float)(rev - rint(rev)) * 6.283185307179586f;
          cs[i] = cosf(fr); sn[i] = sinf(fr); } }
    { const float* x = a.in[I_X]; const float* lw = a.in[I_LN1]; unsigned char* xn = ws + WS_XN; float* sax = (float*)(ws + WS_SAX);
      f32x4 w[8];
#pragma unroll
      for (int j = 0; j < 8; ++j) w[j] = *((const f32x4*)lw + lane + 64 * j);
      f32x4 v[8];
      const bool wgt = (G == 256); const int bx = blockIdx.x;
      const int NSLOT = wgt ? NWAVES * (NSTRIP_IN + 2 * (256 - NSTRIP_IN)) : NGW;
      const int slot0 = wgt ? (bx < NSTRIP_IN ? bx * NWAVES + wave : NSTRIP_IN * NWAVES + (bx - NSTRIP_IN) * 2 * NWAVES + wave) : gw;
      const int nsl = (wgt && bx >= NSTRIP_IN) ? 2 : 1;
      for (int sl = 0; sl < nsl; ++sl) {
      const int rw = slot0 + sl * NWAVES, RNW = NSLOT;
      if (rw >= 0 && rw < S_) { const GAS f32x4* xr = (const GAS f32x4*)(x + (size_t)rw * DM) + lane;
#pragma unroll
          for (int j = 0; j < 8; ++j) v[j] = __builtin_nontemporal_load(xr + 64 * j); }
#pragma unroll 1
      for (int m = rw; m >= 0 && m < S_; m += RNW) { const int mn = (m + RNW < S_) ? m + RNW : m; const GAS f32x4* xr = (const GAS f32x4*)(x + (size_t)mn * DM) + lane;
          f32x4 vn[8]; float s = 0.f;
#pragma unroll
          for (int j = 0; j < 8; ++j) vn[j] = __builtin_nontemporal_load(xr + 64 * j);
#pragma unroll
          for (int j = 0; j < 8; ++j) s += (v[j].x * v[j].x + v[j].y * v[j].y) + (v[j].z * v[j].z + v[j].w * v[j].w);
          const float rstd = 1.f / sqrtf(wave_sum(s) * (1.f / DM) + EPS_); float mx = 0.f;
#pragma unroll
          for (int j = 0; j < 8; ++j) { v[j] = v[j] * rstd * w[j]; mx = fmaxf(fmaxf(mx, fmaxf(fabsf(v[j].x), fabsf(v[j].y))), fmaxf(fabsf(v[j].z), fabsf(v[j].w))); }
          mx = wave_max(mx); const float inv = mx > 0.f ? 127.f / mx : 0.f;
          if (lane == 0) sax[m] = mx * (1.f / 127.f);
          GAS unsigned* o4 = (GAS unsigned*)(xn + (size_t)m * DM) + lane;
#pragma unroll
          for (int j = 0; j < 8; ++j) o4[64 * j] = pk4_i8(v[j].x * inv, v[j].y * inv, v[j].z * inv, v[j].w * inv);
#pragma unroll
          for (int j = 0; j < 8; ++j) v[j] = vn[j]; } } }
}

__device__ __forceinline__ void qk_norm_rope(const Args& a, int wave, int lane, int G) {
    bf16* proj = (bf16*)(a.ws + WS_PROJ); const float* cs = (const float*)(a.ws + WS_COS); const float* sn = (const float*)(a.ws + WS_SIN);
    const int gw = blockIdx.x * NWAVES + wave, NGW = G * NWAVES; const int l16 = lane & 15, sub = lane >> 4;
    float wq[8], wk[8];
#pragma unroll
    for (int e = 0; e < 8; ++e) { wq[e] = a.in[I_QNW][8 * l16 + e]; wk[e] = a.in[I_KNW][8 * l16 + e]; }
    for (int rs = gw * 4 + sub; rs < S_ * 2; rs += NGW * 4) {
        const int t = rs >> 1, j = 8 + (rs & 1); const int col0 = C_AK + (j - 8) * 128 + 8 * l16;
        GAS u32x4* p = (GAS u32x4*)(proj + (size_t)t * PROJ_LD + col0); const u32x4 raw = *p;
        float y[8]; y[0] = bflo(raw.x); y[1] = bfhi(raw.x); y[2] = bflo(raw.y); y[3] = bfhi(raw.y); y[4] = bflo(raw.z); y[5] = bfhi(raw.z); y[6] = bflo(raw.w); y[7] = bfhi(raw.w);
        float s = 0.f;
#pragma unroll
        for (int e = 0; e < 8; ++e) s += y[e] * y[e];
        s += __shfl_xor(s, 1); s += __shfl_xor(s, 2); s += __shfl_xor(s, 4); s += __shfl_xor(s, 8);
        const float rstd = 1.f / sqrtf(s * (1.f / 128.f) + EPS_);
#pragma unroll
        for (int e = 0; e < 8; ++e) y[e] = y[e] * rstd * (j < 8 ? wq[e] : wk[e]);
        float pr[8];
#pragma unroll
        for (int e = 0; e < 8; ++e) pr[e] = __shfl_xor(y[e], 2);
        if (l16 < 4) { const int fi = 8 * (l16 & 1); const float sg = (l16 < 2) ? -1.f : 1.f;
#pragma unroll
            for (int e = 0; e < 8; ++e) { const float c = cs[t * 16 + fi + e], sv = sn[t * 16 + fi + e]; y[e] = y[e] * c + sg * pr[e] * sv; } }
        u32x4 o; o.x = pk2(y[0], y[1]); o.y = pk2(y[2], y[3]); o.z = pk2(y[4], y[5]); o.w = pk2(y[6], y[7]);
        *p = o;
    }
}

#define KSWZ(row, colB) ((row) * 256 + ((colB) ^ (((row) & 7) << 4)))
__device__ __forceinline__ int crow(int r, int hi) { return (r & 3) + 8 * (r >> 2) + 4 * hi; }
__device__ __forceinline__ unsigned cvtpk(float lo, float hi) { unsigned r; asm volatile("v_cvt_pk_bf16_f32 %0, %1, %2" : "=v"(r) : "v"(lo), "v"(hi)); return r; }
__device__ __forceinline__ int v_st(int k, int c) { const int kk = (k & ~0xC) | ((k & 4) << 1) | ((k & 8) >> 1); return ((kk >> 3) * 4 + (c >> 5)) * 512 + ((kk & 7) * 32 + (c & 31)) * 2; }
__device__ __forceinline__ int v_rd_base(int lane) { return ((lane & 3) << 3) | (((lane >> 2) & 3) << 6) | (((lane >> 4) & 1) << 5) | (((lane >> 5) & 1) << 8); }
constexpr int v_rd_off(int d0, int ks, int half) { return d0 * 512 + ks * 4096 + half * 2048; }
template <int OFF> __device__ __forceinline__ s16x4 tr_read(int vb) { s16x4 r; asm volatile("ds_read_b64_tr_b16 %0, %1 offset:%2" : "=&v"(r) : "v"(vb), "i"(OFF) : "memory"); return r; }
template <int D0> __device__ __forceinline__ void pv_one(f32x16& od, int vb, bf16x8 pa0, bf16x8 pa1, bf16x8 pa2, bf16x8 pa3) {
    const s16x4 l0 = tr_read<v_rd_off(D0, 0, 0)>(vb), h0 = tr_read<v_rd_off(D0, 0, 1)>(vb), l1 = tr_read<v_rd_off(D0, 1, 0)>(vb), h1 = tr_read<v_rd_off(D0, 1, 1)>(vb);
    const s16x4 l2 = tr_read<v_rd_off(D0, 2, 0)>(vb), h2 = tr_read<v_rd_off(D0, 2, 1)>(vb), l3 = tr_read<v_rd_off(D0, 3, 0)>(vb), h3 = tr_read<v_rd_off(D0, 3, 1)>(vb);
    asm volatile("s_waitcnt lgkmcnt(0)" ::: "memory"); SBAR();
#define PKV(L, H) (bf16x8){L[0], L[1], L[2], L[3], H[0], H[1], H[2], H[3]}
    od = __builtin_amdgcn_mfma_f32_32x32x16_bf16(pa0, PKV(l0, h0), od, 0, 0, 0);
    od = __builtin_amdgcn_mfma_f32_32x32x16_bf16(pa1, PKV(l1, h1), od, 0, 0, 0);
    od = __builtin_amdgcn_mfma_f32_32x32x16_bf16(pa2, PKV(l2, h2), od, 0, 0, 0);
    od = __builtin_amdgcn_mfma_f32_32x32x16_bf16(pa3, PKV(l3, h3), od, 0, 0, 0);
#undef PKV
}
__device__ __forceinline__ void attn_unit(const Args& a, unsigned char* lds, int tb, int g) {
    constexpr float SCALE = 0.088388347648318440f, C = SCALE * 1.4426950408889634f, NEG = -1e30f;
    const int tid = opaque_tid(), wid = __builtin_amdgcn_readfirstlane(tid >> 6), lane = tid & 63, r32 = lane & 31, hi = lane >> 5;
    const bf16* proj = (const bf16*)(a.ws + WS_PROJ); bf16* araw = (bf16*)(a.ws + WS_ARAW); float* assq = (float*)(a.ws + WS_ASSQ);
    const int t0 = tb * 64, hq = 4 * g + (wid >> 1), qrow = t0 + 32 * (wid & 1) + r32;
    bf16* K_lds = (bf16*)lds; bf16* V_lds = (bf16*)(lds + 16384);
    float* wsf = (float*)(lds + 32768) + wid * 64; float* al_l = wsf; float* li_l = wsf + 32;
    bf16* stg = (bf16*)(lds + 36864) + wid * 4096;
    bf16x8 qr[8];
    { const bf16* Qw = proj + (size_t)qrow * PROJ_LD + C_AQ + hq * 128 + hi * 8;
      u32x4 raw[8];
#pragma unroll
      for (int d0 = 0; d0 < 8; ++d0) raw[d0] = *(const u32x4*)(Qw + d0 * 16);
      float qf[8][8]; float ss = 0.f;
#pragma unroll
      for (int d0 = 0; d0 < 8; ++d0) { qf[d0][0] = bflo(raw[d0].x); qf[d0][1] = bfhi(raw[d0].x); qf[d0][2] = bflo(raw[d0].y); qf[d0][3] = bfhi(raw[d0].y); qf[d0][4] = bflo(raw[d0].z); qf[d0][5] = bfhi(raw[d0].z); qf[d0][6] = bflo(raw[d0].w); qf[d0][7] = bfhi(raw[d0].w);
#pragma unroll
          for (int e = 0; e < 8; ++e) ss += qf[d0][e] * qf[d0][e]; }
      { auto rr = __builtin_amdgcn_permlane32_swap(__float_as_uint(ss), __float_as_uint(ss), false, false); ss = __uint_as_float(rr[0]) + __uint_as_float(rr[1]); }
      const float rstd = 1.f / sqrtf(ss * (1.f / 128.f) + EPS_);
      const float* qnw = a.in[I_QNW] + hi * 8;
#pragma unroll
      for (int d0 = 0; d0 < 8; ++d0) { const f32x4 w0 = *(const f32x4*)(qnw + d0 * 16), w1 = *(const f32x4*)(qnw + d0 * 16 + 4);
          qf[d0][0] *= rstd * w0.x; qf[d0][1] *= rstd * w0.y; qf[d0][2] *= rstd * w0.z; qf[d0][3] *= rstd * w0.w; qf[d0][4] *= rstd * w1.x; qf[d0][5] *= rstd * w1.y; qf[d0][6] *= rstd * w1.z; qf[d0][7] *= rstd * w1.w; }
      { const float* cs = (const float*)(a.ws + WS_COS) + (size_t)qrow * 16 + hi * 8; const float* sn = (const float*)(a.ws + WS_SIN) + (size_t)qrow * 16 + hi * 8;
        const f32x4 c0 = *(const f32x4*)cs, c1 = *(const f32x4*)(cs + 4), s0 = *(const f32x4*)sn, s1 = *(const f32x4*)(sn + 4);
        const float cv[8] = {c0.x, c0.y, c0.z, c0.w, c1.x, c1.y, c1.z, c1.w}, sv[8] = {s0.x, s0.y, s0.z, s0.w, s1.x, s1.y, s1.z, s1.w};
#pragma unroll
        for (int e = 0; e < 8; ++e) { const float y1 = qf[0][e], y2 = qf[1][e]; qf[0][e] = y1 * cv[e] - y2 * sv[e]; qf[1][e] = y2 * cv[e] + y1 * sv[e]; } }
#pragma unroll
      for (int d0 = 0; d0 < 8; ++d0) { u32x4 w; w.x = pk2(qf[d0][0], qf[d0][1]); w.y = pk2(qf[d0][2], qf[d0][3]); w.z = pk2(qf[d0][4], qf[d0][5]); w.w = pk2(qf[d0][6], qf[d0][7]); qr[d0] = __builtin_bit_cast(bf16x8, w); } }
    float m_reg = a.in[I_SINK][hq] * (1.f / SCALE), l_reg = 1.f;
    f32x16 o[4]; o[0] = f32x16{}; o[1] = f32x16{}; o[2] = f32x16{}; o[3] = f32x16{};
    const int sr = tid >> 4, sc = (tid & 15) * 8, vst0 = v_st(sr, sc), vst1 = v_st(32 + sr, sc);
    const int vb0 = (int)(uintptr_t)V_lds + v_rd_base(lane);
    for (int j = 0; j < 5; ++j) {
        const int kt = t0 - 128 + 64 * j;
        if (kt < 0 || kt >= S_) continue;
        { const bf16* Kg = proj + (size_t)kt * PROJ_LD + C_AK + g * 128 + sc; const bf16* Vg = proj + (size_t)kt * PROJ_LD + C_AV + g * 128 + sc;
          const bf16x8 k0 = *(const bf16x8*)(Kg + (size_t)sr * PROJ_LD), k1 = *(const bf16x8*)(Kg + (size_t)(32 + sr) * PROJ_LD);
          const bf16x8 v0 = *(const bf16x8*)(Vg + (size_t)sr * PROJ_LD), v1 = *(const bf16x8*)(Vg + (size_t)(32 + sr) * PROJ_LD);
          *(bf16x8*)((char*)K_lds + KSWZ(sr, sc * 2)) = k0; *(bf16x8*)((char*)K_lds + KSWZ(32 + sr, sc * 2)) = k1;
          *(bf16x8*)((char*)V_lds + vst0) = v0; *(bf16x8*)((char*)V_lds + vst1) = v1; }
        __syncthreads();
        f32x16 p0 = f32x16{}, p1 = f32x16{};
#pragma unroll
        for (int d0 = 0; d0 < 8; ++d0) { const int cb = (d0 * 16 + hi * 8) * 2;
            const bf16x8 b0 = *(const bf16x8*)((const char*)K_lds + KSWZ(r32, cb));
            const bf16x8 b1 = *(const bf16x8*)((const char*)K_lds + KSWZ(32 + r32, cb));
            p0 = __builtin_amdgcn_mfma_f32_32x32x16_bf16(b0, qr[d0], p0, 0, 0, 0);
            p1 = __builtin_amdgcn_mfma_f32_32x32x16_bf16(b1, qr[d0], p1, 0, 0, 0); }
        if (j == 0 || j == 4) {
#pragma unroll
            for (int r = 0; r < 16; ++r) { const int rel = kt + crow(r, hi) - qrow; if (rel < -128 || rel > 128) p0[r] = NEG; if (rel + 32 < -128 || rel + 32 > 128) p1[r] = NEG; } }
        float pmax = p0[0];
#pragma unroll
        for (int r = 1; r < 16; ++r) pmax = fmaxf(pmax, p0[r]);
#pragma unroll
        for (int r = 0; r < 16; ++r) pmax = fmaxf(pmax, p1[r]);
        { auto rr = __builtin_amdgcn_permlane32_swap(__float_as_uint(pmax), __float_as_uint(pmax), false, false); pmax = fmaxf(__uint_as_float(rr[0]), __uint_as_float(rr[1])); }
        const float mn = fmaxf(m_reg, pmax), alpha = __builtin_amdgcn_exp2f((m_reg - mn) * C); m_reg = mn;
        const float mnC = -mn * C;
#pragma unroll
        for (int r = 0; r < 16; ++r) { p0[r] = __builtin_amdgcn_exp2f(fmaf(p0[r], C, mnC)); p1[r] = __builtin_amdgcn_exp2f(fmaf(p1[r], C, mnC)); }
        float ps = 0.f;
#pragma unroll
        for (int r = 0; r < 16; ++r) ps += p0[r] + p1[r];
        { auto rr = __builtin_amdgcn_permlane32_swap(__float_as_uint(ps), __float_as_uint(ps), false, false); ps = __uint_as_float(rr[0]) + __uint_as_float(rr[1]); }
        l_reg = l_reg * alpha + ps;
        if (__any(alpha < 1.f)) { if (hi == 0) al_l[r32] = alpha; LDS_WAIT();
#pragma unroll
            for (int d = 0; d < 4; ++d)
#pragma unroll
                for (int r = 0; r < 16; ++r) o[d][r] *= al_l[crow(r, hi)]; }
        bf16x8 pa0, pa1, pa2, pa3;
#define PK4(P, BASE, OUT) do { unsigned a0 = cvtpk(P[BASE + 0], P[BASE + 1]), a1 = cvtpk(P[BASE + 2], P[BASE + 3]);   \
    unsigned b0 = cvtpk(P[BASE + 4], P[BASE + 5]), b1 = cvtpk(P[BASE + 6], P[BASE + 7]);                              \
    auto r0 = __builtin_amdgcn_permlane32_swap(a0, b0, false, false); auto r1 = __builtin_amdgcn_permlane32_swap(a1, b1, false, false); \
    u32x4 w = {r0[0], r1[0], r0[1], r1[1]}; OUT = *reinterpret_cast<bf16x8*>(&w); } while (0)
        PK4(p0, 0, pa0); PK4(p0, 8, pa1); PK4(p1, 0, pa2); PK4(p1, 8, pa3);
#undef PK4
        SBAR();
        pv_one<0>(o[0], vb0, pa0, pa1, pa2, pa3); pv_one<1>(o[1], vb0, pa0, pa1, pa2, pa3); pv_one<2>(o[2], vb0, pa0, pa1, pa2, pa3); pv_one<3>(o[3], vb0, pa0, pa1, pa2, pa3);
        __syncthreads();
    }
    if (hi == 0) li_l[r32] = l_reg; LDS_WAIT();
#pragma unroll
    for (int r = 0; r < 16; ++r) { const int orow = crow(r, hi); const float rl = __builtin_amdgcn_rcpf(li_l[orow]);
#pragma unroll
        for (int d0 = 0; d0 < 4; ++d0) stg[orow * 128 + d0 * 32 + r32] = (bf16)f2bf(o[d0][r] * rl); }
    LDS_WAIT();
#pragma unroll
    for (int i = 0; i < 8; ++i) { const int row = i * 4 + (lane >> 4), ch = lane & 15; const u32x4 v = *(const u32x4*)(stg + row * 128 + ch * 8);
        const int tok = t0 + 32 * (wid & 1) + row;
        *(u32x4*)(araw + (size_t)tok * 1024 + hq * 128 + ch * 8) = v;
        float s = bflo(v.x) * bflo(v.x) + bfhi(v.x) * bfhi(v.x) + bflo(v.y) * bflo(v.y) + bfhi(v.y) * bfhi(v.y) + bflo(v.z) * bflo(v.z) + bfhi(v.z) * bfhi(v.z) + bflo(v.w) * bflo(v.w) + bfhi(v.w) * bfhi(v.w);
        s += __shfl_xor(s, 1); s += __shfl_xor(s, 2); s += __shfl_xor(s, 4); s += __shfl_xor(s, 8);
        if (ch == 0) assq[tok * 8 + hq] = s; }
    __syncthreads();
}


constexpr int GL_BIAS = 0, GL_QD = 512, GL_KI = GL_QD + 17408, GL_KET = GL_KI + 17408, GL_VR = GL_KET + 18432, GL_ATT = GL_VR + 36864, GL_DEC = GL_ATT + 9216;
template <int OFF> __device__ __forceinline__ s16x4 tr_read_g(int vb) { s16x4 r; asm volatile("ds_read_b64_tr_b16 %0, %1 offset:%2" : "=&v"(r) : "v"(vb), "i"(OFF) : "memory"); return r; }
#define DPP_ADD(v, ctrl, rmask) v += __builtin_bit_cast(float, __builtin_amdgcn_update_dpp(0, __builtin_bit_cast(int, v), ctrl, rmask, 0xF, false))
template <int PASS> __device__ __forceinline__ void gla_unit(const Args& a, unsigned char* lds, int dir, int head, int sc) {
    const int tid = opaque_tid(), wid = __builtin_amdgcn_readfirstlane(tid >> 6), lane = tid & 63, r32 = lane & 31, hi = lane >> 5;
    const bf16* proj = (const bf16*)(a.ws + WS_PROJ);
    float* BIAS = (float*)(lds + GL_BIAS); float* DEC = (float*)(lds + GL_DEC);
    char* QD = (char*)(lds + GL_QD); char* KI = (char*)(lds + GL_KI); char* KET = (char*)(lds + GL_KET); char* VR = (char*)(lds + GL_VR); char* ATT = (char*)(lds + GL_ATT);
    const float* upg = a.in[dir ? I_UPB : I_UPF];
    if (tid < 128) BIAS[tid] = a.in[dir ? I_BB : I_BF][head * 128 + tid];
    bf16x8 Aup;
    { float u[8];
#pragma unroll
      for (int jj = 0; jj < 8; ++jj) u[jj] = (r32 < 16) ? upg[(8 * hi + jj) * 512 + head * 128 + 16 * wid + r32] : 0.f;
      u32x4 w; w.x = pk2(u[0], u[1]); w.y = pk2(u[2], u[3]); w.z = pk2(u[4], u[5]); w.w = pk2(u[6], u[7]); Aup = __builtin_bit_cast(bf16x8, w); }
    const int dh = dir * 4 + head;
    f32x16 St[4];
    if (PASS == 3) { const float* sin_st = (const float*)(a.ws + WS_SIN_ST) + ((size_t)dh * 32 + sc) * 32768;
#pragma unroll
        for (int db = 0; db < 4; ++db)
#pragma unroll
            for (int r = 0; r < 16; ++r) St[db][r] = sin_st[(32 * db + crow(r, hi)) * 256 + 32 * wid + r32];
    } else { St[0] = f32x16{}; St[1] = f32x16{}; St[2] = f32x16{}; St[3] = f32x16{}; }
    float bsum[8];
#pragma unroll
    for (int c = 0; c < 8; ++c) bsum[c] = 0.f;
    u32x4 rq[2], rk[2], rv[4], rl[2];
#define GLA_TOK(CI, ROW) (dir ? (S_ - 1 - (sc * 512 + (CI) * 64 + (ROW))) : (sc * 512 + (CI) * 64 + (ROW)))
#define GLA_LOAD(CI) do { \
        _Pragma("unroll") for (int i_ = 0; i_ < 2; ++i_) { const int c_ = tid + 512 * i_, row_ = c_ >> 4, ch_ = c_ & 15; const bf16* p_ = proj + (size_t)GLA_TOK(CI, row_) * PROJ_LD + head * 128 + ch_ * 8; \
            rk[i_] = *(const u32x4*)(p_ + C_GK); if (PASS == 3) rq[i_] = *(const u32x4*)(p_ + C_GQ); } \
        _Pragma("unroll") for (int i_ = 0; i_ < 4; ++i_) { const int c_ = tid + 512 * i_, row_ = c_ >> 5, ch_ = c_ & 31; rv[i_] = *(const u32x4*)(proj + (size_t)GLA_TOK(CI, row_) * PROJ_LD + C_GV + head * 256 + ch_ * 8); } \
        _Pragma("unroll") for (int b_ = 0; b_ < 2; ++b_) rl[b_] = *(const u32x4*)(proj + (size_t)GLA_TOK(CI, 32 * b_ + r32) * PROJ_LD + (dir ? C_LRB : C_LRF) + 8 * hi); } while (0)
    GLA_LOAD(0);
    const int vb = (int)(uintptr_t)VR + (8 * hi + ((lane & 15) >> 2)) * 576 + (32 * wid + 16 * ((lane >> 4) & 1) + 4 * (lane & 3)) * 2;
    __syncthreads();
#pragma unroll 1
    for (int ci = 0; ci < 8; ++ci) {
#pragma unroll
        for (int i = 0; i < 2; ++i) { const int c = tid + 512 * i, row = c >> 4, ch = c & 15; *(u32x4*)(KI + row * 272 + ch * 16) = rk[i]; if (PASS == 3) *(u32x4*)(QD + row * 272 + ch * 16) = rq[i]; }
#pragma unroll
        for (int i = 0; i < 4; ++i) { const int c = tid + 512 * i, row = c >> 5, ch = c & 31; *(u32x4*)(VR + row * 576 + ch * 16) = rv[i]; }
        const bf16x8 lrB0 = __builtin_bit_cast(bf16x8, rl[0]), lrB1 = __builtin_bit_cast(bf16x8, rl[1]);
        { const int cn = ci < 7 ? ci + 1 : 7; GLA_LOAD(cn); }
        __syncthreads();
        {
          f32x16 g0 = __builtin_amdgcn_mfma_f32_32x32x16_bf16(Aup, lrB0, f32x16{}, 0, 0, 0), g1 = __builtin_amdgcn_mfma_f32_32x32x16_bf16(Aup, lrB1, f32x16{}, 0, 0, 0);
          const f32x4 bia = *(const f32x4*)(BIAS + 16 * wid + 4 * hi), bib = *(const f32x4*)(BIAS + 16 * wid + 8 + 4 * hi);
          float b0[8], b1[8];
#pragma unroll
          for (int j = 0; j < 8; ++j) { const float bi = j < 4 ? bia[j & 3] : bib[j & 3];
              float x0 = g0[j] + bi, x1 = g1[j] + bi;
              x0 = (fminf(x0, 0.f) - __logf(1.f + __expf(-fabsf(x0)))) * (1.f / 16.f); x1 = (fminf(x1, 0.f) - __logf(1.f + __expf(-fabsf(x1)))) * (1.f / 16.f);
              DPP_ADD(x0, 0x111, 0xF); DPP_ADD(x0, 0x112, 0xF); DPP_ADD(x0, 0x114, 0xF); DPP_ADD(x0, 0x118, 0xF); DPP_ADD(x0, 0x142, 0xA);
              DPP_ADD(x1, 0x111, 0xF); DPP_ADD(x1, 0x112, 0xF); DPP_ADD(x1, 0x114, 0xF); DPP_ADD(x1, 0x118, 0xF); DPP_ADD(x1, 0x142, 0xA);
              const float t0a = __builtin_bit_cast(float, __builtin_amdgcn_readlane(__builtin_bit_cast(int, x0), 31)), t0b = __builtin_bit_cast(float, __builtin_amdgcn_readlane(__builtin_bit_cast(int, x0), 63));
              x1 += hi ? t0b : t0a;
              b0[j] = x0; b1[j] = x1; }
          float blast[8];
#pragma unroll
          for (int j = 0; j < 8; ++j) { const float la = __builtin_bit_cast(float, __builtin_amdgcn_readlane(__builtin_bit_cast(int, b1[j]), 31)), lb = __builtin_bit_cast(float, __builtin_amdgcn_readlane(__builtin_bit_cast(int, b1[j]), 63));
              blast[j] = hi ? lb : la; bsum[j] += blast[j]; }
          float dec[8];
#pragma unroll
          for (int j = 0; j < 8; ++j) dec[j] = __expf(blast[j]);
          if (r32 == 0) { *(f32x4*)(DEC + 16 * wid + 4 * hi) = (f32x4){dec[0], dec[1], dec[2], dec[3]}; *(f32x4*)(DEC + 16 * wid + 8 + 4 * hi) = (f32x4){dec[4], dec[5], dec[6], dec[7]}; }
#pragma unroll
          for (int blk = 0; blk < 2; ++blk) { const int tok = 32 * blk + r32; const float* bb = blk ? b1 : b0;
              char* kp = KI + tok * 272 + (16 * wid + 4 * hi) * 2; const u32x2 ka = *(const u32x2*)kp, kb = *(const u32x2*)(kp + 16);
              const float kf[8] = {bflo(ka.x), bfhi(ka.x), bflo(ka.y), bfhi(ka.y), bflo(kb.x), bfhi(kb.x), bflo(kb.y), bfhi(kb.y)};
              float ki[8];
#pragma unroll
              for (int j = 0; j < 8; ++j) ki[j] = kf[j] * __expf(-bb[j]);
              bf16* ket = (bf16*)KET + (16 * wid + 4 * hi) * 72 + tok;
#pragma unroll
              for (int j = 0; j < 8; ++j) ket[((j & 3) + 8 * (j >> 2)) * 72] = (bf16)f2bf(ki[j] * dec[j]);
              if (PASS == 3) {
                  u32x2 wa, wb; wa.x = pk2(ki[0], ki[1]); wa.y = pk2(ki[2], ki[3]); wb.x = pk2(ki[4], ki[5]); wb.y = pk2(ki[6], ki[7]);
                  *(u32x2*)kp = wa; *(u32x2*)(kp + 16) = wb;
                  char* qp = QD + tok * 272 + (16 * wid + 4 * hi) * 2; const u32x2 qa = *(const u32x2*)qp, qb = *(const u32x2*)(qp + 16);
                  const float qf[8] = {bflo(qa.x), bfhi(qa.x), bflo(qa.y), bfhi(qa.y), bflo(qb.x), bfhi(qb.x), bflo(qb.y), bfhi(qb.y)};
                  float qd[8];
#pragma unroll
                  for (int j = 0; j < 8; ++j) qd[j] = qf[j] * 0.088388347648318440f * __expf(bb[j]);
                  wa.x = pk2(qd[0], qd[1]); wa.y = pk2(qd[2], qd[3]); wb.x = pk2(qd[4], qd[5]); wb.y = pk2(qd[6], qd[7]);
                  *(u32x2*)qp = wa; *(u32x2*)(qp + 16) = wb; } }
        }
        __syncthreads();
        f32x16 oT[2]; oT[0] = f32x16{}; oT[1] = f32x16{};
        if (PASS == 3) {
#pragma unroll
            for (int e = 0; e < 2; ++e) { const int blk = 2 * wid + e, jb = blk >> 2, cb = blk & 3; const int l15 = lane & 15, l4 = lane >> 4;
                f32x4 acc = {0.f, 0.f, 0.f, 0.f};
                if (jb <= cb) {
#pragma unroll
                    for (int ks = 0; ks < 4; ++ks) { const bf16x8 A = *(const bf16x8*)(KI + (16 * jb + l15) * 272 + (8 * l4 + 32 * ks) * 2); const bf16x8 B = *(const bf16x8*)(QD + (16 * cb + l15) * 272 + (8 * l4 + 32 * ks) * 2);
                        acc = __builtin_amdgcn_mfma_f32_16x16x32_bf16(A, B, acc, 0, 0, 0); }
                    const int c = 16 * cb + l15, j0 = 16 * jb + 4 * l4;
#pragma unroll
                    for (int r = 0; r < 4; ++r) if (j0 + r > c) acc[r] = 0.f;
                }
                u32x2 w; w.x = pk2(acc[0], acc[1]); w.y = pk2(acc[2], acc[3]);
                *(u32x2*)(ATT + (16 * cb + l15) * 144 + (16 * jb + 4 * l4) * 2) = w; }
            __syncthreads();
        }
        bf16x8 Vf[4];
        { const s16x4 a0 = tr_read_g<0>(vb), c0 = tr_read_g<2304>(vb), a1 = tr_read_g<9216>(vb), c1 = tr_read_g<9216 + 2304>(vb);
          const s16x4 a2 = tr_read_g<18432>(vb), c2 = tr_read_g<18432 + 2304>(vb), a3 = tr_read_g<27648>(vb), c3 = tr_read_g<27648 + 2304>(vb);
          asm volatile("s_waitcnt lgkmcnt(0)" ::: "memory"); SBAR();
          Vf[0] = (bf16x8){a0[0], a0[1], a0[2], a0[3], c0[0], c0[1], c0[2], c0[3]}; Vf[1] = (bf16x8){a1[0], a1[1], a1[2], a1[3], c1[0], c1[1], c1[2], c1[3]};
          Vf[2] = (bf16x8){a2[0], a2[1], a2[2], a2[3], c2[0], c2[1], c2[2], c2[3]}; Vf[3] = (bf16x8){a3[0], a3[1], a3[2], a3[3], c3[0], c3[1], c3[2], c3[3]}; }
        if (PASS == 3) {
#pragma unroll
            for (int cb2 = 0; cb2 < 2; ++cb2) {
#pragma unroll
                for (int ks = 0; ks < 4; ++ks) { if (cb2 == 0 && ks >= 2) continue;
                    const bf16x8 B = *(const bf16x8*)(ATT + (32 * cb2 + r32) * 144 + (16 * ks + 8 * hi) * 2);
                    oT[cb2] = __builtin_amdgcn_mfma_f32_32x32x16_bf16(Vf[ks], B, oT[cb2], 0, 0, 0); }
#pragma unroll
                for (int db = 0; db < 4; ++db)
#pragma unroll
                    for (int s = 0; s < 2; ++s) { u32x4 sw; sw.x = cvtpk(St[db][8 * s + 0], St[db][8 * s + 1]); sw.y = cvtpk(St[db][8 * s + 2], St[db][8 * s + 3]); sw.z = cvtpk(St[db][8 * s + 4], St[db][8 * s + 5]); sw.w = cvtpk(St[db][8 * s + 6], St[db][8 * s + 7]);
                        const char* qp = QD + (32 * cb2 + r32) * 272 + (32 * db + 16 * s + 4 * hi) * 2; const u32x2 blo = *(const u32x2*)qp, bhi2 = *(const u32x2*)(qp + 16);
                        const u32x4 bw = {blo.x, blo.y, bhi2.x, bhi2.y};
                        oT[cb2] = __builtin_amdgcn_mfma_f32_32x32x16_bf16(__builtin_bit_cast(bf16x8, sw), __builtin_bit_cast(bf16x8, bw), oT[cb2], 0, 0, 0); }
            }
        }
#pragma unroll
        for (int db = 0; db < 4; ++db) {
#pragma unroll
            for (int g4 = 0; g4 < 4; ++g4) { const f32x4 dv = *(const f32x4*)(DEC + 32 * db + 8 * g4 + 4 * hi); St[db][4 * g4 + 0] *= dv[0]; St[db][4 * g4 + 1] *= dv[1]; St[db][4 * g4 + 2] *= dv[2]; St[db][4 * g4 + 3] *= dv[3]; }
#pragma unroll
            for (int ks = 0; ks < 4; ++ks) { const bf16x8 A = *(const bf16x8*)(KET + (32 * db + r32) * 144 + (16 * ks + 8 * hi) * 2);
                St[db] = __builtin_amdgcn_mfma_f32_32x32x16_bf16(A, Vf[ks], St[db], 0, 0, 0); }
        }
        if (PASS == 3) { bf16* od = (bf16*)(a.ws + WS_OF) + (size_t)dir * S_ * 1024;
#pragma unroll
            for (int cb2 = 0; cb2 < 2; ++cb2) { const int t = GLA_TOK(ci, 32 * cb2 + r32); bf16* op = od + (size_t)t * 1024 + head * 256 + 32 * wid + 8 * hi;
#pragma unroll
                for (int p = 0; p < 2; ++p) {
                    const unsigned ax = cvtpk(oT[cb2][8 * p + 0], oT[cb2][8 * p + 1]), ay = cvtpk(oT[cb2][8 * p + 2], oT[cb2][8 * p + 3]);
                    const unsigned bx = cvtpk(oT[cb2][8 * p + 4], oT[cb2][8 * p + 5]), by = cvtpk(oT[cb2][8 * p + 6], oT[cb2][8 * p + 7]);
                    auto r0 = __builtin_amdgcn_permlane32_swap(ax, bx, false, false); auto r1 = __builtin_amdgcn_permlane32_swap(ay, by, false, false);
                    const u32x4 w = {r0[0], r1[0], r0[1], r1[1]};
                    *(u32x4*)(op + 16 * p) = w; } } }
        __syncthreads();
    }
#undef GLA_LOAD
#undef GLA_TOK
    if (PASS == 1) { float* ds = (float*)(a.ws + WS_DS) + ((size_t)dh * 32 + sc) * 32768;
#pragma unroll
        for (int db = 0; db < 4; ++db)
#pragma unroll
            for (int r = 0; r < 16; ++r) ds[(32 * db + crow(r, hi)) * 256 + 32 * wid + r32] = St[db][r];
        if (r32 == 0) { float* dt = (float*)(a.ws + WS_DECT) + (dh * 32 + sc) * 128 + 16 * wid + 4 * hi;
#pragma unroll
            for (int j = 0; j < 8; ++j) dt[(j & 3) + 8 * (j >> 2)] = __expf(bsum[j]); } }
}
#undef DPP_ADD
__device__ __forceinline__ void gla_scan(const Args& a, int G) {
    const float* ds = (const float*)(a.ws + WS_DS); const float* dt = (const float*)(a.ws + WS_DECT); float* si = (float*)(a.ws + WS_SIN_ST);
    const int gt = blockIdx.x * NTHREADS + threadIdx.x, NGT = G * NTHREADS;
    for (int idx = gt; idx < 8 * 32768; idx += NGT) { const int dh = idx >> 15, el = idx & 32767, d = el >> 8;
        float x[32], dc[32];
#pragma unroll
        for (int sc = 0; sc < 32; ++sc) { x[sc] = ds[((size_t)dh * 32 + sc) * 32768 + el]; dc[sc] = dt[(dh * 32 + sc) * 128 + d]; }
        float s = 0.f;
#pragma unroll
        for (int sc = 0; sc < 32; ++sc) { si[((size_t)dh * 32 + sc) * 32768 + el] = s; s = dc[sc] * s + x[sc]; } }
}

__device__ __forceinline__ void finalize_mixed(const Args& a, int wave, int lane, int G) {
    unsigned char* mixed = a.ws + WS_MIX; float* sam = (float*)(a.ws + WS_SAM); const bf16* araw = (const bf16*)(a.ws + WS_ARAW); const float* assq = (const float*)(a.ws + WS_ASSQ); const bf16* proj = (const bf16*)(a.ws + WS_PROJ);
    const bf16* of = (const bf16*)(a.ws + WS_OF); const bf16* ob = of + (size_t)S_ * 1024;
    const int gw = blockIdx.x * NWAVES + wave, NGW = G * NWAVES; const int hi = lane >> 5, l31 = lane & 31;
    float anw[16], gnw[8];
#pragma unroll
    for (int i = 0; i < 2; ++i)
#pragma unroll
        for (int e = 0; e < 8; ++e) anw[i * 8 + e] = a.in[I_ANW][512 * i + lane * 8 + e];
#pragma unroll
    for (int e = 0; e < 8; ++e) gnw[e] = a.in[I_GNW][l31 * 8 + e];
    for (int t = gw; t < S_; t += NGW) {
        u32x4 va[2], vf[2], vb[2], vg[2];
#pragma unroll
        for (int i = 0; i < 2; ++i) va[i] = *(const GAS u32x4*)(araw + (size_t)t * 1024 + 512 * i + lane * 8);
#pragma unroll
        for (int j = 0; j < 2; ++j) { const int c = (2 * j + hi) * 256 + 8 * l31; vf[j] = *(const GAS u32x4*)(of + (size_t)t * 1024 + c); vb[j] = *(const GAS u32x4*)(ob + (size_t)t * 1024 + c); vg[j] = *(const GAS u32x4*)(proj + (size_t)t * PROJ_LD + C_GR + c); }
        const float tot = wave_sum(lane < 8 ? assq[t * 8 + lane] : 0.f);
        const float rstd = 1.f / sqrtf(tot * (1.f / 1024.f) + EPS_);
        float av[16], gv[16]; float mx = 0.f;
#pragma unroll
        for (int i = 0; i < 2; ++i) { const u32x4 v = va[i]; const float* w = anw + i * 8; float* o = av + i * 8;
            o[0] = bflo(v.x) * rstd * w[0]; o[1] = bfhi(v.x) * rstd * w[1]; o[2] = bflo(v.y) * rstd * w[2]; o[3] = bfhi(v.y) * rstd * w[3];
            o[4] = bflo(v.z) * rstd * w[4]; o[5] = bfhi(v.z) * rstd * w[5]; o[6] = bflo(v.w) * rstd * w[6]; o[7] = bfhi(v.w) * rstd * w[7]; }
#pragma unroll
        for (int j = 0; j < 2; ++j) { const u32x4 f = vf[j], b = vb[j], g = vg[j];
            float o8[8] = {bflo(f.x) + bflo(b.x), bfhi(f.x) + bfhi(b.x), bflo(f.y) + bflo(b.y), bfhi(f.y) + bfhi(b.y), bflo(f.z) + bflo(b.z), bfhi(f.z) + bfhi(b.z), bflo(f.w) + bflo(b.w), bfhi(f.w) + bfhi(b.w)};
            const float gg[8] = {bflo(g.x), bfhi(g.x), bflo(g.y), bfhi(g.y), bflo(g.z), bfhi(g.z), bflo(g.w), bfhi(g.w)};
            float ss = 0.f;
#pragma unroll
            for (int e = 0; e < 8; ++e) ss += o8[e] * o8[e];
            ss += WV_DPP(ss, 0x111, 0xF); ss += WV_DPP(ss, 0x112, 0xF); ss += WV_DPP(ss, 0x114, 0xF); ss += WV_DPP(ss, 0x118, 0xF); ss += WV_DPP(ss, 0x142, 0xA);
            const float slo = __builtin_bit_cast(float, __builtin_amdgcn_readlane(__builtin_bit_cast(int, ss), 31)), shi = __builtin_bit_cast(float, __builtin_amdgcn_readlane(__builtin_bit_cast(int, ss), 63));
            const float rs = 1.f / sqrtf((hi ? shi : slo) * (1.f / 256.f) + EPS_);
#pragma unroll
            for (int e = 0; e < 8; ++e) gv[j * 8 + e] = o8[e] * rs * gnw[e] * pg8::silu_f(gg[e]); }
#pragma unroll
        for (int e = 0; e < 16; ++e) mx = fmaxf(mx, fmaxf(fabsf(av[e]), fabsf(gv[e])));
        mx = wave_max(mx); const float inv = mx > 0.f ? 127.f / mx : 0.f;
        if (lane == 0) sam[t] = mx * (1.f / 127.f);
#pragma unroll
        for (int i = 0; i < 2; ++i) { u32x2 w; w.x = pk4_i8(av[i * 8 + 0] * inv, av[i * 8 + 1] * inv, av[i * 8 + 2] * inv, av[i * 8 + 3] * inv); w.y = pk4_i8(av[i * 8 + 4] * inv, av[i * 8 + 5] * inv, av[i * 8 + 6] * inv, av[i * 8 + 7] * inv);
            *(GAS u32x2*)(mixed + (size_t)t * DM + 512 * i + lane * 8) = w; }
#pragma unroll
        for (int j = 0; j < 2; ++j) { u32x2 w; w.x = pk4_i8(gv[j * 8 + 0] * inv, gv[j * 8 + 1] * inv, gv[j * 8 + 2] * inv, gv[j * 8 + 3] * inv); w.y = pk4_i8(gv[j * 8 + 4] * inv, gv[j * 8 + 5] * inv, gv[j * 8 + 6] * inv, gv[j * 8 + 7] * inv);
            *(GAS u32x2*)(mixed + (size_t)t * DM + 1024 + (2 * j + hi) * 256 + 8 * l31) = w; }
    }
}

__device__ __forceinline__ void router_block(const Args& a, unsigned char* lds, int tb) {
    const int tid = opaque_tid(), wid = __builtin_amdgcn_readfirstlane(tid >> 6), lane = tid & 63, l15 = lane & 15, l4 = lane >> 4;
    const bf16* h = (const bf16*)(a.ws + WS_H); const float* lw = a.in[I_LN2];
    unsigned char* xn2 = a.ws + WS_XN2; const bf16* wr = (const bf16*)(a.ws + WS_WR);
    char* At = (char*)lds;
    float* part = (float*)lds;
    float* rsl = (float*)(lds + 100352); int* cntl = (int*)(lds + 100352 + 256);
    pg8::f32x4 acc[4][3];
#pragma unroll
    for (int rb = 0; rb < 4; ++rb)
#pragma unroll
        for (int nb = 0; nb < 3; ++nb) acc[rb][nb] = (pg8::f32x4){0.f, 0.f, 0.f, 0.f};
    float ssq[8];
#pragma unroll
    for (int rr = 0; rr < 8; ++rr) ssq[rr] = 0.f;
    u32x4 hn[8];
#pragma unroll
    for (int rr = 0; rr < 8; ++rr) hn[rr] = *(const u32x4*)(h + ((size_t)tb * 64 + 8 * wid + rr) * DM + 8 * lane);
#pragma unroll 1
    for (int kc = 0; kc < 4; ++kc) {
        const f32x4 w0 = *(const f32x4*)(lw + kc * 512 + 8 * lane), w1 = *(const f32x4*)(lw + kc * 512 + 8 * lane + 4);
#pragma unroll
        for (int rr = 0; rr < 8; ++rr) { const int row = 8 * wid + rr; const size_t t = (size_t)tb * 64 + row;
            const u32x4 hv = hn[rr];
            const float f0 = bflo(hv.x), f1 = bfhi(hv.x), f2 = bflo(hv.y), f3 = bfhi(hv.y), f4 = bflo(hv.z), f5 = bfhi(hv.z), f6 = bflo(hv.w), f7 = bfhi(hv.w);
            ssq[rr] += (f0 * f0 + f1 * f1) + (f2 * f2 + f3 * f3) + (f4 * f4 + f5 * f5) + (f6 * f6 + f7 * f7);
            const float a0 = f0 * w0.x, a1 = f1 * w0.y, a2 = f2 * w0.z, a3 = f3 * w0.w, a4 = f4 * w1.x, a5 = f5 * w1.y, a6 = f6 * w1.z, a7 = f7 * w1.w;
            u32x4 p; p.x = pk2(a0, a1); p.y = pk2(a2, a3); p.z = pk2(a4, a5); p.w = pk2(a6, a7);
            *(u32x4*)(At + row * 1040 + (8 * lane) * 2) = p;
            u32x2 q8; q8.x = pg8::pk4_fp8(a0, a1, a2, a3); q8.y = pg8::pk4_fp8(a4, a5, a6, a7);
            *(u32x2*)(xn2 + t * XN2_P + kc * 512 + 8 * lane) = q8; }
        { const int kn = kc < 3 ? kc + 1 : 3;
#pragma unroll
          for (int rr = 0; rr < 8; ++rr) hn[rr] = *(const u32x4*)(h + ((size_t)tb * 64 + 8 * wid + rr) * DM + kn * 512 + 8 * lane); }
        bf16x8 B[2][3];
#pragma unroll
        for (int k2 = 0; k2 < 2; ++k2)
#pragma unroll
            for (int nb = 0; nb < 3; ++nb) B[k2][nb] = *(const bf16x8*)(wr + (size_t)(16 * nb + l15) * DM + kc * 512 + 32 * (2 * wid + k2) + 8 * l4);
        __syncthreads();
#pragma unroll
        for (int k2 = 0; k2 < 2; ++k2) { const int ks = 2 * wid + k2;
#pragma unroll
            for (int rb = 0; rb < 4; ++rb) { const bf16x8 A = *(const bf16x8*)(At + (16 * rb + l15) * 1040 + (32 * ks + 8 * l4) * 2);
#pragma unroll
                for (int nb = 0; nb < 3; ++nb) acc[rb][nb] = __builtin_amdgcn_mfma_f32_16x16x32_bf16(A, B[k2][nb], acc[rb][nb], 0, 0, 0); } }
        __syncthreads();
    }
#pragma unroll
    for (int rr = 0; rr < 8; ++rr) { const float s = wave_sum(ssq[rr]); if (lane == 0) rsl[8 * wid + rr] = 1.f / sqrtf(s * (1.f / DM) + EPS_); }
#pragma unroll
    for (int rb = 0; rb < 4; ++rb)
#pragma unroll
        for (int nb = 0; nb < 3; ++nb)
#pragma unroll
            for (int r = 0; r < 4; ++r) part[(wid * 64 + 16 * rb + 4 * l4 + r) * 48 + 16 * nb + l15] = acc[rb][nb][r];
    if (tid < 32) cntl[tid] = 0;
    __syncthreads();
    if (tid < 64) { const int token = tb * 64 + tid; const float rstd = rsl[tid];
        float gl[4];
#pragma unroll
        for (int n = 0; n < 4; ++n) { float s = 0.f;
#pragma unroll
            for (int w = 0; w < 8; ++w) s += part[(w * 64 + tid) * 48 + n];
            gl[n] = s * rstd + a.in[I_BG][n]; }
        int gs = 0; float gm = gl[0];
#pragma unroll
        for (int n = 1; n < 4; ++n) if (gl[n] > gm) { gm = gl[n]; gs = n; }
        float den = 0.f;
#pragma unroll
        for (int n = 0; n < 4; ++n) den += __expf(gl[n] - gm);
        const float gate = 1.f / den;
        float el[8];
#pragma unroll
        for (int j = 0; j < 8; ++j) { float s = 0.f;
#pragma unroll
            for (int w = 0; w < 8; ++w) s += part[(w * 64 + tid) * 48 + 4 + gs * 8 + j];
            el[j] = s * rstd + a.in[I_BR][gs * 8 + j]; }
        int i0 = 0; float v0 = el[0];
#pragma unroll
        for (int j = 1; j < 8; ++j) if (el[j] > v0) { v0 = el[j]; i0 = j; }
        int i1 = -1; float v1 = -3.0e38f;
#pragma unroll
        for (int j = 0; j < 8; ++j) if (j != i0 && el[j] > v1) { v1 = el[j]; i1 = j; }
        const float ex = __expf(v1 - v0), p0 = 1.f / (1.f + ex), p1 = ex * p0;
        int* te = (int*)(a.ws + WS_TOKE); float* tw = (float*)(a.ws + WS_TOKW); float* tr = (float*)(a.ws + WS_TOKR);
        te[token * 2] = gs * 8 + i0; te[token * 2 + 1] = gs * 8 + i1; tw[token * 2] = gate * p0; tw[token * 2 + 1] = gate * p1; tr[token] = rstd;
        atomicAdd(&cntl[gs * 8 + i0], 1); atomicAdd(&cntl[gs * 8 + i1], 1); }
    __syncthreads();
    if (tid < 32) ((int*)(a.ws + WS_CNT))[tb * 32 + tid] = cntl[tid];
    __syncthreads();
}
__device__ __forceinline__ void assign_block(const Args& a, unsigned char* lds, int tb) {
    const int tid = opaque_tid(), wid = __builtin_amdgcn_readfirstlane(tid >> 6), lane = tid & 63;
    const int* cnt = (const int*)(a.ws + WS_CNT); const int* te = (const int*)(a.ws + WS_TOKE); const float* tw = (const float*)(a.ws + WS_TOKW); const float* tr = (const float*)(a.ws + WS_TOKR);
    int* sdst = (int*)(a.ws + WS_SDST); float* sw = (float*)(a.ws + WS_SW); float* srs = (float*)(a.ws + WS_SRS); int* tile_e = (int*)(a.ws + WS_TILEE);
    int* L_tot = (int*)lds; int* L_bef = L_tot + 32; int* L_ps = L_bef + 32; int* L_base = L_ps + 40; int* L_e = L_base + 32; int* L_slot = L_e + 128;
    { int* L_pt = L_slot + 128; int* L_pb = L_pt + 512;
      const int e = tid & 31, seg = tid >> 5; int tot = 0, bef = 0;
#pragma unroll
      for (int i = 0; i < 16; ++i) { const int b = seg * 16 + i; const int c = cnt[b * 32 + e]; tot += c; bef += (b < tb) ? c : 0; }
      L_pt[tid] = tot; L_pb[tid] = bef; }
    __syncthreads();
    if (tid < 32) { int tot = 0, bef = 0;
#pragma unroll
        for (int s = 0; s < 16; ++s) { tot += L_slot[128 + s * 32 + tid]; bef += L_slot[128 + 512 + s * 32 + tid]; }
        L_tot[tid] = tot; L_bef[tid] = bef; }
    __syncthreads();
    if (tid == 0) { int p = 0; for (int e = 0; e < 32; ++e) { L_ps[e] = p; L_base[e] = p + L_bef[e]; p += (L_tot[e] + 255) & ~255; } L_ps[32] = p; }
    if (tid < 128) L_e[tid] = te[tb * 128 + tid];
    __syncthreads();
    if (tid < 128) { const int e = L_e[tid]; int rank = 0; for (int a2 = 0; a2 < tid; ++a2) rank += (L_e[a2] == e) ? 1 : 0;
        const int slot = L_base[e] + rank, token = tb * 64 + (tid >> 1), k = tid & 1; L_slot[tid] = slot;
        sdst[slot] = k * S_ + token; sw[slot] = tw[token * 2 + k]; srs[slot] = tr[token]; }
    __syncthreads();
    if (tb == 0) {
        for (int e = 0; e < 32; ++e) { const int st = L_ps[e] + L_tot[e], en = L_ps[e] + ((L_tot[e] + 255) & ~255);
            for (int s = st + tid; s < en; s += NTHREADS) { sdst[s] = -1; sw[s] = 0.f; srs[s] = 0.f; } }
        if (tid < 32) { const int t0 = L_ps[tid] >> 8, t1 = (L_ps[tid] + ((L_tot[tid] + 255) & ~255)) >> 8; for (int t = t0; t < t1; ++t) tile_e[t] = tid; }
        if (tid == 0) tile_e[MAX_TILES] = L_ps[32] >> 8;
    }
    __syncthreads();
}

template <int CLS> __device__ __forceinline__ void conv_share(const Args& a, int it0, int nitems, LAS unsigned char* lds, int wave, int lane, int G, int cls) {
    const bool split = (G % 16) == 0; const int b = blockIdx.x;
    if (!split) { if (cls == 0) titem_run<CLS>(a, it0, nitems, b * NWAVES + wave, G * NWAVES, (LAS float*)(lds + wave * 16384), lane); return; }
    if (((b >> 3) & 1) != cls) return;
    const int rank = (b >> 4) * 8 + (b & 7), half = nitems / 2;
    titem_run<CLS>(a, it0 + cls * half, cls ? nitems - half : half, rank * NWAVES + wave, (G / 2) * NWAVES, (LAS float*)(lds + wave * 16384), lane);
}

__global__ void __launch_bounds__(NTHREADS, 2) hymba_fwd(Args args) {
    extern __shared__ __attribute__((aligned(16))) unsigned char lds[];
    LAS unsigned char* ldsl = (LAS unsigned char*)lds;
    const int tid = opaque_tid(), lane = tid & 63, wave = __builtin_amdgcn_readfirstlane(tid >> 6);
    const int G = gridDim.x;
    unsigned char* ws = args.ws;
    for (int u = tid; u < (LDS_BYTES - LDSCTL_OFF) / 4; u += NTHREADS) ((LAS unsigned*)(ldsl + LDSCTL_OFF))[u] = 0u;
    __syncthreads();
    volatile LAS unsigned* MISC = (volatile LAS unsigned*)(ldsl + MISC_OFF);
    XcdBarrier bar = xcd_barrier_post((unsigned*)(ws + WS_CTL) + CW_BAR, MISC + 8);

    p0_prologue(args, ldsl, wave, lane, G);
    xcd_barrier(bar);
    { pg8::Gemm g{ws + WS_XN, ws + WS_WIN, DM, DM, DM, 128, 128, (size_t)256 * DM, (size_t)256 * DM}; pg8::StaticOrder S; S.init(S_, PROJ_LD, G, (int)blockIdx.x);
      pg8::EpiBf16Q E{(bf16*)(ws + WS_PROJ), PROJ_LD, (const float*)(ws + WS_SAX), (const float*)(ws + WS_CTL) + CW_CMAX_IN};
      pg8::gemm_phase<pg8::EpiBf16Q, pg8::StaticOrder, 2>(ldsl, g, S, E); }
    {
      const int nfull = (S_ / 256) * (PROJ_LD / 256) % G; const int first = (nfull != 0 && G - nfull >= 1) ? nfull : 0, nhost = G - first;
      __syncthreads();
      for (int s = (int)blockIdx.x - first; s >= 0 && s < 64; s += nhost) p0_strip(args, 145 + s, (LAS float*)(ldsl + wave * 16384), (LAS float*)(ldsl + TILEE_OFF + 1024), wave, lane); }
    xcd_barrier(bar);
    qk_norm_rope(args, wave, lane, G);
#if MK_STAGE >= 2
    __syncthreads();
    conv_share<1>(args, 0, 32 * 512, ldsl, wave, lane, G, 0);
    __syncthreads();
    for (int u = blockIdx.x; u < 256; u += G) gla_unit<1>(args, lds, u >> 7, (u >> 5) & 3, (u >> 7) ? 31 - (u & 31) : (u & 31));
    __syncthreads();
    conv_share<1>(args, 0, 32 * 512, ldsl, wave, lane, G, 1);
#endif
    xcd_barrier(bar);
#if MK_STAGE >= 2
    gla_scan(args, G);
#endif
    __syncthreads();
    conv_share<0>(args, 0, 32 * 512, ldsl, wave, lane, G, 0);
    __syncthreads();
    for (int u = blockIdx.x; u < 512; u += G) attn_unit(args, lds, u >> 1, u & 1);
    __syncthreads();
    conv_share<0>(args, 0, 32 * 512, ldsl, wave, lane, G, 1);
    xcd_barrier(bar);
#if MK_STAGE >= 2
    conv_share<0>(args, 32 * 512, 32 * 512, ldsl, wave, lane, G, 0);
    __syncthreads();
    for (int u = blockIdx.x; u < 256; u += G) gla_unit<3>(args, lds, u >> 7, (u >> 5) & 3, (u >> 7) ? 31 - (u & 31) : (u & 31));
    __syncthreads();
    conv_share<0>(args, 32 * 512, 32 * 512, ldsl, wave, lane, G, 1);
    xcd_barrier(bar);
#endif
    finalize_mixed(args, wave, lane, G);
    xcd_barrier(bar);
    { pg8::Gemm g{ws + WS_MIX, ws + WS_WOUT, DM, DM, DM, 128, 128, (size_t)256 * DM, (size_t)256 * DM}; pg8::StaticOrder S; S.init(S_, DM, G, (int)blockIdx.x);
      pg8::EpiResBf16Q E{(bf16*)(ws + WS_H), args.in[I_X], DM, (const float*)(ws + WS_SAM), (const float*)(ws + WS_CTL) + CW_CMAX_OUT};
      pg8::gemm_phase<pg8::EpiResBf16Q, pg8::StaticOrder, 2>(ldsl, g, S, E); }
#if MK_STAGE >= 3
    xcd_barrier(bar);
    for (int tb = blockIdx.x; tb < 256; tb += G) router_block(args, lds, tb);
    xcd_barrier(bar);
    for (int tb = blockIdx.x; tb < 256; tb += G) assign_block(args, lds, tb);
    xcd_barrier(bar);
    LAS int* tile_lds = (LAS int*)(ldsl + TILEE_OFF);
    if (tid <= MAX_TILES) tile_lds[tid] = ((const int*)(ws + WS_TILEE))[tid];
    __syncthreads();
    const int n_tiles = __builtin_amdgcn_readfirstlane(tile_lds[MAX_TILES]);
    { pg8::Gemm g{ws + WS_XN2, ws + WS_WGU, DM, XN2_P, 128, 128, 32768, 0, (size_t)256 * DM}; pg8::MoeOrder S; LAS int* tokl = (LAS int*)(ldsl + TILEE_OFF + 2048); S.init(n_tiles, 8, G, (int)blockIdx.x, tile_lds, tokl);
      { pg8::Unit u; const int* sdst = (const int*)(ws + WS_SDST);
        for (int i = 0; i < 12 && S.next(i, u); ++i) if (tid < 256) { const int d = sdst[u.pm * 256 + tid]; tokl[i * 256 + tid] = d < 0 ? 0 : (d & (S_ - 1)); } }
      __syncthreads();
      pg8::EpiSwiGLU E{ws + WS_HID, (const float*)(ws + WS_SRS)};
      pg8::gemm_phase<pg8::EpiSwiGLU, pg8::MoeOrder, 1, true>(ldsl, g, S, E); }
    xcd_barrier(bar);
    { pg8::Gemm g{ws + WS_HID, ws + WS_WD, DFF, 128, 128, 32768, 32768, (size_t)256 * DFF, (size_t)256 * DFF}; pg8::MoeOrder S; S.init(n_tiles, 8, G, (int)blockIdx.x, tile_lds);
      pg8::EpiMoeOut E{ws + WS_Y, (const int*)(ws + WS_SDST), (const float*)(ws + WS_SW)};
      pg8::gemm_phase<pg8::EpiMoeOut, pg8::MoeOrder, 1>(ldsl, g, S, E); }
    xcd_barrier(bar);
    { const int gt = blockIdx.x * NTHREADS + tid, NGT = G * NTHREADS; const unsigned char* Y0 = ws + WS_Y; const unsigned char* Y1 = Y0 + (size_t)S_ * DM; const bf16* H = (const bf16*)(ws + WS_H);
      typedef float f32x2_t __attribute__((ext_vector_type(2)));
      constexpr int NIT = S_ * DM / 8, UNR = 4;
      for (int i0 = gt; i0 < NIT; i0 += NGT * UNR) {
          u32x4 hv[UNR]; u32x2 y0[UNR], y1[UNR];
#pragma unroll
          for (int u = 0; u < UNR; ++u) { const int i = i0 + u * NGT; if (i < NIT) { hv[u] = *((const GAS u32x4*)H + i); y0[u] = *((const GAS u32x2*)Y0 + i); y1[u] = *((const GAS u32x2*)Y1 + i); } }
#pragma unroll
          for (int u = 0; u < UNR; ++u) { const int i = i0 + u * NGT; if (i < NIT) { GAS f32x4* o = (GAS f32x4*)args.out + 2 * (size_t)i;
              const f32x2_t a0 = __builtin_amdgcn_cvt_pk_f32_fp8(y0[u].x, false), a1 = __builtin_amdgcn_cvt_pk_f32_fp8(y0[u].x, true), a2 = __builtin_amdgcn_cvt_pk_f32_fp8(y0[u].y, false), a3 = __builtin_amdgcn_cvt_pk_f32_fp8(y0[u].y, true);
              const f32x2_t b0 = __builtin_amdgcn_cvt_pk_f32_fp8(y1[u].x, false), b1 = __builtin_amdgcn_cvt_pk_f32_fp8(y1[u].x, true), b2 = __builtin_amdgcn_cvt_pk_f32_fp8(y1[u].y, false), b3 = __builtin_amdgcn_cvt_pk_f32_fp8(y1[u].y, true);
              f32x4 r0, r1; r0.x = bflo(hv[u].x) + (a0.x + b0.x) * pg8::YUNSCALE; r0.y = bfhi(hv[u].x) + (a0.y + b0.y) * pg8::YUNSCALE; r0.z = bflo(hv[u].y) + (a1.x + b1.x) * pg8::YUNSCALE; r0.w = bfhi(hv[u].y) + (a1.y + b1.y) * pg8::YUNSCALE;
              r1.x = bflo(hv[u].z) + (a2.x + b2.x) * pg8::YUNSCALE; r1.y = bfhi(hv[u].z) + (a2.y + b2.y) * pg8::YUNSCALE; r1.z = bflo(hv[u].w) + (a3.x + b3.x) * pg8::YUNSCALE; r1.w = bfhi(hv[u].w) + (a3.y + b3.y) * pg8::YUNSCALE;
              o[0] = r0; o[1] = r1; } } } }
#endif
}

extern "C" void kernel_launch(void* const* d_in, const int* in_sizes, int n_in, void* d_out, int out_size, void* d_ws, size_t ws_size, hipStream_t stream) {
    static int grid = 0;
    if (grid == 0) {
        if (n_in != 21 || in_sizes[0] != S_ * DM || out_size != S_ * DM || ws_size < WS_END) { fprintf(stderr, "kernel_launch: unexpected shapes (n_in %d, in0 %d, out %d, ws %zu); nothing launched\n", n_in, n_in > 0 ? in_sizes[0] : -1, out_size, ws_size); grid = -1; return; }
        int dev = 0, cus = 0, per_cu = 0;
        if (hipGetDevice(&dev) != hipSuccess || hipDeviceGetAttribute(&cus, hipDeviceAttributeMultiprocessorCount, dev) != hipSuccess) { grid = -1; return; }
        if (hipFuncSetAttribute((const void*)hymba_fwd, hipFuncAttributeMaxDynamicSharedMemorySize, LDS_BYTES) != hipSuccess) { fprintf(stderr, "kernel_launch: hipFuncSetAttribute failed\n"); grid = -1; return; }
        if (hipOccupancyMaxActiveBlocksPerMultiprocessor(&per_cu, (const void*)hymba_fwd, NTHREADS, LDS_BYTES) != hipSuccess || per_cu < 1) { fprintf(stderr, "kernel_launch: occupancy query says %d blocks per CU\n", per_cu); (void)hipGetLastError(); grid = -1; return; }
        grid = cus;
    }
    if (grid < 0) return;
    (void)hipMemsetAsync((char*)d_ws + WS_CTL, 0, CTL_ZERO_BYTES, stream);
    Args a{};
    for (int i = 0; i < 21; ++i) a.in[i] = (const float*)d_in[i];
    a.out = (float*)d_out; a.ws = (unsigned char*)d_ws;
    hipLaunchKernelGGL(hymba_fwd, dim3(grid), dim3(NTHREADS), LDS_BYTES, stream, a);
}
```

```cpp
#include <hip/hip_runtime.h>
#include <cstdio>
#include <cstdint>

#ifndef MK_STAGE
#define MK_STAGE 3
#endif

constexpr int S_ = 16384, DM = 2048;
constexpr int PROJ_LD = 4864;
constexpr int C_AQ = 0, C_AK = 1024, C_AV = 1280, C_GQ = 1536, C_GK = 2048, C_GV = 2560, C_GR = 3584, C_LRF = 4608, C_LRB = 4624, IN_W = 4640;
constexpr float EPS_ = 1e-6f;
constexpr int NE = 32, DFF = 1024;
constexpr int P_XS = 2048 + 128, P_HID = 1024 + 128;
constexpr int MAX_TILES = 160, MAX_SLOTS = MAX_TILES * 256;

__device__ __forceinline__ int opaque_tid() { int t = threadIdx.x; asm volatile("" : "+v"(t)); return t; }
namespace pg8 {
#define PG8_LAS __attribute__((address_space(3)))
typedef unsigned short bf16_t;
typedef short bf16x8 __attribute__((ext_vector_type(8)));
typedef float f32x4 __attribute__((ext_vector_type(4)));
typedef unsigned u32x4 __attribute__((ext_vector_type(4)));
constexpr int BM = 256, BK = 64, HALF = 128, HTB = HALF * BK * 2, STAGE_BYTES = 8 * HTB, NXCD = 8, WGM = 8;

__host__ __device__ __forceinline__ int lds_byte(int r, int c) { const int st = (r >> 4) * 2 + (c >> 5), rr = r & 15, cc = c & 31, ob = rr * 64 + cc * 2; return st * 1024 + (ob ^ (((ob >> 9) & 1) << 5)); }
__host__ __device__ __forceinline__ void stage_rc(int b, int& R, int& C) { const int st = b / 1024, sb = b % 1024, swz = sb ^ (((sb >> 9) & 1) << 5); R = (st >> 1) * 16 + swz / 64; C = (st & 1) * 32 + (swz % 64) / 2; }
__host__ __device__ __forceinline__ int perm32(int rho) { const int n = rho >> 4, i = rho & 15; return 8 * (i >> 2) + 4 * n + (i & 3); }

typedef int v4i_q __attribute__((ext_vector_type(4)));
struct Unit { int pm, pn, pb; };
struct Gemm { const void* A; const void* Bt; int Kb; int pa, pb, ka, kb; size_t ta, tb; };

struct StaticOrder {
    int nM, nN, nwg, G, c;
    __device__ void init(int M, int N, int G_, int c_) { nM = M / BM; nN = N / BM; nwg = nM * nN; G = G_; c = c_; }
    __device__ bool next(int i, Unit& u) const {
        const long L = (long)i * G + c; if (L >= nwg) return false;
        int wgid = (int)L; { const int q = nwg / NXCD, r = nwg % NXCD, xcd = wgid % NXCD, off = wgid / NXCD; wgid = (xcd < r ? xcd * (q + 1) : r * (q + 1) + (xcd - r) * q) + off; }
        const int nig = WGM * nN, gid = wgid / nig, fm = gid * WGM, gsz = (nM - fm) < WGM ? (nM - fm) : WGM;
        u.pm = fm + ((wgid % nig) % gsz); u.pn = (wgid % nig) / gsz; u.pb = u.pn; return true;
    }
};
struct MoeOrder {
    int nM, nN, nwg, G, c; const PG8_LAS int* tile_e; const PG8_LAS int* tokl;
    __device__ void init(int nM_, int nN_, int G_, int c_, const PG8_LAS int* te, const PG8_LAS int* tl = nullptr) { nM = nM_; nN = nN_; nwg = nM * nN; G = G_; c = c_; tile_e = te; tokl = tl; }
    __device__ bool next(int i, Unit& u) const {
        const long L = (long)i * G + c; if (L >= nwg) return false;
        int wgid = (int)L; { const int q = nwg / NXCD, r = nwg % NXCD, xcd = wgid % NXCD, off = wgid / NXCD; wgid = (xcd < r ? xcd * (q + 1) : r * (q + 1) + (xcd - r) * q) + off; }
        const int nig = WGM * nN, gid = wgid / nig, fm = gid * WGM, gsz = (nM - fm) < WGM ? (nM - fm) : WGM;
        u.pm = fm + ((wgid % nig) % gsz); u.pn = (wgid % nig) / gsz; u.pb = tile_e[u.pm] * nN + u.pn; return true;
    }
};

__device__ __forceinline__ unsigned cvt_pk_bf16(float lo, float hi) { unsigned r; asm volatile("v_cvt_pk_bf16_f32 %0, %1, %2" : "=v"(r) : "v"(lo), "v"(hi)); return r; }

struct EpiBf16Q {
    static constexpr bool PERM = true;
    bf16_t* O; int ldc; const float* sa; const float* cmax;
    __device__ __forceinline__ void operator()(const f32x4 (&acc)[2][2][4][2], const Unit& u, int wr, int wc, int fr, int fq) const {
        const int row0 = u.pm * BM + wr * 64 + fr, col0 = u.pn * BM + wc * 32 + 8 * fq;
        f32x4 cs[2][2];
#pragma unroll
        for (int bj = 0; bj < 2; ++bj)
#pragma unroll
            for (int n = 0; n < 2; ++n) cs[bj][n] = *(const f32x4*)(cmax + col0 + bj * HALF + 4 * n) * (1.f / 127.f);
        float sav[2][4];
#pragma unroll
        for (int ai = 0; ai < 2; ++ai)
#pragma unroll
            for (int m = 0; m < 4; ++m) sav[ai][m] = sa[row0 + ai * HALF + m * 16];
#pragma unroll
        for (int ai = 0; ai < 2; ++ai)
#pragma unroll
            for (int m = 0; m < 4; ++m) { const int row = row0 + ai * HALF + m * 16; const float s = sav[ai][m]; bf16_t* rowp = O + (size_t)row * ldc + col0;
#pragma unroll
                for (int bj = 0; bj < 2; ++bj) { const v4i_q i0 = __builtin_bit_cast(v4i_q, acc[ai][bj][m][0]), i1 = __builtin_bit_cast(v4i_q, acc[ai][bj][m][1]);
                    const f32x4 v0 = __builtin_convertvector(i0, f32x4) * cs[bj][0] * s, v1 = __builtin_convertvector(i1, f32x4) * cs[bj][1] * s;
                    u32x4 w; w.x = cvt_pk_bf16(v0[0], v0[1]); w.y = cvt_pk_bf16(v0[2], v0[3]); w.z = cvt_pk_bf16(v1[0], v1[1]); w.w = cvt_pk_bf16(v1[2], v1[3]);
                    *(u32x4*)(rowp + bj * HALF) = w; } }
    }
};
struct EpiResBf16Q {
    static constexpr bool PERM = true;
    bf16_t* H; const float* R; int ldc; const float* sa; const float* cmax;
    __device__ __forceinline__ void operator()(const f32x4 (&acc)[2][2][4][2], const Unit& u, int wr, int wc, int fr, int fq) const {
        const int row0 = u.pm * BM + wr * 64 + fr, col0 = u.pn * BM + wc * 32 + 8 * fq;
        f32x4 cs[2][2];
#pragma unroll
        for (int bj = 0; bj < 2; ++bj)
#pragma unroll
            for (int n = 0; n < 2; ++n) cs[bj][n] = *(const f32x4*)(cmax + col0 + bj * HALF + 4 * n) * (1.f / 127.f);
        float sav[2][4];
#pragma unroll
        for (int ai = 0; ai < 2; ++ai)
#pragma unroll
            for (int m = 0; m < 4; ++m) sav[ai][m] = sa[row0 + ai * HALF + m * 16];
#pragma unroll
        for (int ai = 0; ai < 2; ++ai)
#pragma unroll
            for (int m = 0; m < 4; ++m) { const int row = row0 + ai * HALF + m * 16; const float s = sav[ai][m]; const size_t ro = (size_t)row * ldc + col0;
#pragma unroll
                for (int bj = 0; bj < 2; ++bj) { const f32x4 r0 = __builtin_nontemporal_load((const f32x4*)(R + ro + bj * HALF)), r1 = __builtin_nontemporal_load((const f32x4*)(R + ro + bj * HALF + 4));
                    const v4i_q i0 = __builtin_bit_cast(v4i_q, acc[ai][bj][m][0]), i1 = __builtin_bit_cast(v4i_q, acc[ai][bj][m][1]);
                    const f32x4 v0 = __builtin_convertvector(i0, f32x4) * cs[bj][0] * s + r0, v1 = __builtin_convertvector(i1, f32x4) * cs[bj][1] * s + r1;
                    u32x4 w; w.x = cvt_pk_bf16(v0[0], v0[1]); w.y = cvt_pk_bf16(v0[2], v0[3]); w.z = cvt_pk_bf16(v1[0], v1[1]); w.w = cvt_pk_bf16(v1[2], v1[3]);
                    *(u32x4*)(H + ro + bj * HALF) = w; } }
    }
};
__device__ __forceinline__ float silu_f(float g) { return g * __builtin_amdgcn_rcpf(1.f + __builtin_amdgcn_exp2f(-1.4426950408889634f * g)); }
__device__ __forceinline__ unsigned pk4_fp8(float a, float b, float c, float d) { int w = 0; w = __builtin_amdgcn_cvt_pk_fp8_f32(a, b, w, false); w = __builtin_amdgcn_cvt_pk_fp8_f32(c, d, w, true); return (unsigned)w; }
constexpr float WSCALE = 64.f, WUNSCALE = 1.f / 64.f;
struct EpiSwiGLU {
    static constexpr bool PERM = true;
    unsigned char* H; const float* rs;
    __device__ __forceinline__ void operator()(const f32x4 (&acc)[2][2][4][2], const Unit& u, int wr, int wc, int fr, int fq) const {
        const int row0 = u.pm * BM + wr * 64 + fr, col0 = u.pn * HALF + wc * 32 + 8 * fq;
        float rsv[2][4];
#pragma unroll
        for (int ai = 0; ai < 2; ++ai)
#pragma unroll
            for (int m = 0; m < 4; ++m) rsv[ai][m] = rs[row0 + ai * HALF + m * 16];
#pragma unroll
        for (int ai = 0; ai < 2; ++ai)
#pragma unroll
            for (int m = 0; m < 4; ++m) { const int row = row0 + ai * HALF + m * 16; const float r = rsv[ai][m] * WUNSCALE;
                float h[8];
#pragma unroll
                for (int n = 0; n < 2; ++n)
#pragma unroll
                    for (int e = 0; e < 4; ++e) h[n * 4 + e] = silu_f(acc[ai][0][m][n][e] * r) * (acc[ai][1][m][n][e] * r);
                unsigned w0 = pk4_fp8(h[0], h[1], h[2], h[3]), w1 = pk4_fp8(h[4], h[5], h[6], h[7]);
                typedef unsigned u32x2_t __attribute__((ext_vector_type(2)));
                *(u32x2_t*)(H + (size_t)u.pm * (256 * DFF) + (size_t)u.pn * 32768 + (row & 255) * 128 + wc * 32 + 8 * fq) = (u32x2_t){w0, w1}; }
    }
};
constexpr float YSCALE = 16.f, YUNSCALE = 1.f / 16.f;
struct EpiMoeOut {
    static constexpr bool PERM = true;
    unsigned char* Y; const int* dst; const float* w;
    __device__ __forceinline__ void operator()(const f32x4 (&acc)[2][2][4][2], const Unit& u, int wr, int wc, int fr, int fq) const {
        const int row0 = u.pm * BM + wr * 64 + fr, col0 = u.pn * BM + wc * 64 + 16 * fq;
        int dv[2][4]; float wv[2][4];
#pragma unroll
        for (int ai = 0; ai < 2; ++ai)
#pragma unroll
            for (int m = 0; m < 4; ++m) { dv[ai][m] = dst[row0 + ai * HALF + m * 16]; wv[ai][m] = w[row0 + ai * HALF + m * 16]; }
#pragma unroll
        for (int ai = 0; ai < 2; ++ai)
#pragma unroll
            for (int m = 0; m < 4; ++m) { const int d = dv[ai][m]; const float ww = wv[ai][m] * (WUNSCALE * YSCALE);
                if (d >= 0) { const f32x4 v0 = acc[ai][0][m][0] * ww, v1 = acc[ai][0][m][1] * ww, v2 = acc[ai][1][m][0] * ww, v3 = acc[ai][1][m][1] * ww;
                    *(u32x4*)(Y + (size_t)d * DM + col0) = (u32x4){pk4_fp8(v0[0], v0[1], v0[2], v0[3]), pk4_fp8(v1[0], v1[1], v1[2], v1[3]), pk4_fp8(v2[0], v2[1], v2[2], v2[3]), pk4_fp8(v3[0], v3[1], v3[2], v3[3])}; } }
    }
};

typedef int v4i_t __attribute__((ext_vector_type(4)));
typedef int v8i_t __attribute__((ext_vector_type(8)));
template <class Epi, class Sched, int MODE = 0, bool GATHER = false>
__device__ __forceinline__ void gemm_phase(PG8_LAS unsigned char* lds, const Gemm g, const Sched& S, const Epi& E) {
    const int tid = opaque_tid(), wid = __builtin_amdgcn_readfirstlane(tid >> 6), lane = tid & 63, wr = wid >> 2, wc = wid & 3, fr = lane & 15, fq = lane >> 4;
    const int Kb = g.Kb, nt = Kb / (BK * 2);
    unsigned voffA[2], voffB[2];
#pragma unroll
    for (int i = 0; i < 2; ++i) { int R, C; stage_rc(tid * 16 + i * 8192, R, C); const int Rb = Epi::PERM ? ((R & ~31) + perm32(R & 31)) : R;
        voffA[i] = (unsigned)(R * g.pa + C * 2); voffB[i] = (unsigned)(Rb * g.pb + C * 2); }
    unsigned vA[2][2] = {{0u, 0u}, {0u, 0u}}, vN[2][2] = {{0u, 0u}, {0u, 0u}}; int gR[2] = {0, 0}; unsigned gC[2] = {0u, 0u};
    if constexpr (GATHER) {
#pragma unroll
        for (int i = 0; i < 2; ++i) { int R, C; stage_rc(tid * 16 + i * 8192, R, C); gR[i] = R; gC[i] = (unsigned)(C * 2); }
#pragma unroll
        for (int h = 0; h < 2; ++h)
#pragma unroll
            for (int i = 0; i < 2; ++i) vA[h][i] = (unsigned)S.tokl[gR[i] + HALF * h] * (unsigned)g.pa + gC[i]; }
    const size_t kstepA = (size_t)g.ka, kstepB = (size_t)g.kb;
    const size_t hstepA = (size_t)HALF * g.pa, hstepB = (size_t)HALF * g.pb;
    const size_t tstepA = g.ta, tstepB = g.tb;
    const unsigned ldsw = (unsigned)wid * 1024u;
    const int aoff = lds_byte(wr * 64 + fr, fq * 8), boff = lds_byte(wc * 32 + fr, fq * 8);
#define PG8_SA(b, h) (((b) * 2 + (h)) * HTB)
#define PG8_SB(b, h) ((4 + (b) * 2 + (h)) * HTB)
#define PG8_STAGE(bufoff, gbase, voff) do { _Pragma("unroll") for (int _i = 0; _i < 2; ++_i) \
        __builtin_amdgcn_global_load_lds((const unsigned*)((const char*)(gbase) + (voff)[_i]), (PG8_LAS unsigned*)(lds + (bufoff) + ldsw + _i * 8192), 16, 0, 0); } while (0)
#define PG8_STAGE_A(bufoff, kptr, h, nx) do { if constexpr (GATHER) { _Pragma("unroll") for (int _i = 0; _i < 2; ++_i) \
        __builtin_amdgcn_global_load_lds((const unsigned*)((const char*)(kptr) + ((nx) ? vN[h][_i] : vA[h][_i])), (PG8_LAS unsigned*)(lds + (bufoff) + ldsw + _i * 8192), 16, 0, 0); } \
        else PG8_STAGE(bufoff, (kptr) + ((h) ? hstepA : (size_t)0), voffA); } while (0)
#define PG8_LD8(p) __builtin_shufflevector(*(const PG8_LAS v4i_t*)(p), *(const PG8_LAS v4i_t*)((p) + 1024), 0, 1, 2, 3, 4, 5, 6, 7)
#define PG8_LDA(dst, b, h) do { _Pragma("unroll") for (int m = 0; m < 4; ++m) dst[m] = PG8_LD8(lds + PG8_SA(b, h) + aoff + m * 2048); } while (0)
#define PG8_LDB(dst, b, h) do { _Pragma("unroll") for (int n = 0; n < 2; ++n) dst[n] = PG8_LD8(lds + PG8_SB(b, h) + boff + n * 2048); } while (0)
#define PG8_LO(v) __builtin_bit_cast(bf16x8, __builtin_shufflevector(v, v, 0, 1, 2, 3))
#define PG8_HI(v) __builtin_bit_cast(bf16x8, __builtin_shufflevector(v, v, 4, 5, 6, 7))
#define PG8_LO4(v) __builtin_shufflevector(v, v, 0, 1, 2, 3)
#define PG8_HI4(v) __builtin_shufflevector(v, v, 4, 5, 6, 7)
#define PG8_MMA(ai, bj, At, Bt) do { __builtin_amdgcn_s_setprio(1); _Pragma("unroll") for (int m = 0; m < 4; ++m) _Pragma("unroll") for (int n = 0; n < 2; ++n) { \
        if constexpr (MODE == 1) { asm volatile("v_mfma_scale_f32_16x16x128_f8f6f4 %0, %1, %2, %0, %3, %3 op_sel_hi:[0,0,0]" : "+v"(acc[ai][bj][m][n]) : "v"(Bt[n]), "v"(At[m]), "v"(sc127)); } \
        else if constexpr (MODE == 2) { v4i_t c_ = __builtin_bit_cast(v4i_t, acc[ai][bj][m][n]); c_ = __builtin_amdgcn_mfma_i32_16x16x64_i8(PG8_LO4(Bt[n]), PG8_LO4(At[m]), c_, 0, 0, 0); \
               c_ = __builtin_amdgcn_mfma_i32_16x16x64_i8(PG8_HI4(Bt[n]), PG8_HI4(At[m]), c_, 0, 0, 0); acc[ai][bj][m][n] = __builtin_bit_cast(f32x4, c_); } \
        else { acc[ai][bj][m][n] = __builtin_amdgcn_mfma_f32_16x16x32_bf16(PG8_LO(Bt[n]), PG8_LO(At[m]), acc[ai][bj][m][n], 0, 0, 0); \
               acc[ai][bj][m][n] = __builtin_amdgcn_mfma_f32_16x16x32_bf16(PG8_HI(Bt[n]), PG8_HI(At[m]), acc[ai][bj][m][n], 0, 0, 0); } } \
        __builtin_amdgcn_s_setprio(0); } while (0)
#define PG8_WAIT_V(n) asm volatile("s_waitcnt vmcnt(" #n ")" ::: "memory")
#define PG8_WAIT_L(n) asm volatile("s_waitcnt lgkmcnt(" #n ")" ::: "memory")
#define PG8_BAR __builtin_amdgcn_s_barrier()
#define PG8_SCHED __builtin_amdgcn_sched_barrier(0)
    Unit cur, nxt; int ui = 0;
    if (!S.next(0, cur)) return;
    int sc127 = 127; asm volatile("" : "+v"(sc127));
    f32x4 acc[2][2][4][2];
#pragma unroll
    for (int a = 0; a < 2; ++a)
#pragma unroll
        for (int b = 0; b < 2; ++b)
#pragma unroll
            for (int m = 0; m < 4; ++m)
#pragma unroll
                for (int n = 0; n < 2; ++n) acc[a][b][m][n] = (f32x4){0.f, 0.f, 0.f, 0.f};
    v8i_t At[4], B0[2], B1[2];
    const char* cA = (const char*)g.A + (GATHER ? (size_t)0 : (size_t)cur.pm * tstepA); const char* cB = (const char*)g.Bt + (size_t)cur.pb * tstepB;
    PG8_STAGE(PG8_SB(0, 0), cB, voffB); PG8_STAGE(PG8_SB(0, 1), cB + hstepB, voffB); PG8_STAGE_A(PG8_SA(0, 0), cA, 0, false); PG8_STAGE_A(PG8_SA(0, 1), cA, 1, false);
    if (wr == 1) PG8_BAR;
    PG8_WAIT_V(2); PG8_BAR;
    PG8_STAGE(PG8_SB(1, 0), cB + kstepB, voffB); PG8_STAGE_A(PG8_SA(1, 0), cA + kstepA, 0, false); PG8_STAGE(PG8_SB(1, 1), cB + hstepB + kstepB, voffB);
    PG8_WAIT_V(6); PG8_BAR;
    for (;;) {
        const bool has_next = S.next(ui + 1, nxt);
        const char* nA = (has_next && !GATHER) ? (const char*)g.A + (size_t)nxt.pm * tstepA : cA; const char* nB = has_next ? (const char*)g.Bt + (size_t)nxt.pb * tstepB : cB;
        if constexpr (GATHER) { const int ub = has_next ? (ui + 1) * 256 : ui * 256;
#pragma unroll
            for (int h = 0; h < 2; ++h)
#pragma unroll
                for (int i = 0; i < 2; ++i) vN[h][i] = (unsigned)S.tokl[ub + gR[i] + HALF * h] * (unsigned)g.pa + gC[i]; }
        for (int t = 0; t < nt; t += 2) {
            const bool last = (t == nt - 2);
            const char* a1 = cA + (size_t)(t + 1) * kstepA;
            const char* a2 = last ? nA : cA + (size_t)(t + 2) * kstepA; const char* b2 = last ? nB : cB + (size_t)(t + 2) * kstepB;
            const char* a3 = a2 + kstepA; const char* b3 = b2 + kstepB;
            PG8_LDB(B0, 0, 0); PG8_LDB(B1, 0, 1); PG8_SCHED; PG8_LDA(At, 0, 0); PG8_STAGE_A(PG8_SA(1, 1), a1, 1, false);
            PG8_WAIT_V(8); PG8_WAIT_L(0); PG8_BAR; PG8_MMA(0, 0, At, B0); PG8_MMA(0, 1, At, B1); PG8_BAR; PG8_SCHED;
            PG8_LDA(At, 0, 1); PG8_STAGE(PG8_SB(0, 0), b2, voffB); PG8_STAGE(PG8_SB(0, 1), b2 + hstepB, voffB); PG8_STAGE_A(PG8_SA(0, 0), a2, 0, last);
            PG8_WAIT_V(8); PG8_WAIT_L(0); PG8_BAR; PG8_MMA(1, 0, At, B0); PG8_MMA(1, 1, At, B1); PG8_BAR; PG8_SCHED;
            PG8_LDB(B0, 1, 0); PG8_LDB(B1, 1, 1); PG8_SCHED; PG8_LDA(At, 1, 0); PG8_STAGE_A(PG8_SA(0, 1), a2, 1, last);
            PG8_WAIT_V(8); PG8_WAIT_L(0); PG8_BAR; PG8_MMA(0, 0, At, B0); PG8_MMA(0, 1, At, B1); PG8_BAR; PG8_SCHED;
            PG8_LDA(At, 1, 1); PG8_STAGE(PG8_SB(1, 0), b3, voffB); PG8_STAGE(PG8_SB(1, 1), b3 + hstepB, voffB); PG8_STAGE_A(PG8_SA(1, 0), a3, 0, last);
            PG8_WAIT_V(8); PG8_WAIT_L(0); PG8_BAR; PG8_MMA(1, 0, At, B0); PG8_MMA(1, 1, At, B1); PG8_BAR; PG8_SCHED;
        }
        if (wr == 0) PG8_BAR;
        if constexpr (MODE == 1) asm volatile("s_nop 15\n\ts_nop 15" ::: "memory");
        E(acc, cur, wr, wc, fr, fq);
        if constexpr (MODE == 1) asm volatile("s_nop 7" ::: "memory");
        if (!has_next) break;
#pragma unroll
        for (int a = 0; a < 2; ++a)
#pragma unroll
            for (int b = 0; b < 2; ++b)
#pragma unroll
                for (int m = 0; m < 4; ++m)
#pragma unroll
                    for (int n = 0; n < 2; ++n) acc[a][b][m][n] = (f32x4){0.f, 0.f, 0.f, 0.f};
        cur = nxt; cA = nA; cB = nB; ++ui;
        if constexpr (GATHER) { vA[0][0] = vN[0][0]; vA[0][1] = vN[0][1]; vA[1][0] = vN[1][0]; vA[1][1] = vN[1][1]; }
        if (wr == 1) PG8_BAR;
    }
    PG8_WAIT_V(0);
    PG8_BAR;
#undef PG8_SA
#undef PG8_SB
#undef PG8_STAGE
#undef PG8_STAGE_A
#undef PG8_LDA
#undef PG8_LDB
#undef PG8_LD8
#undef PG8_LO
#undef PG8_HI
#undef PG8_LO4
#undef PG8_HI4
#undef PG8_MMA
#undef PG8_WAIT_V
#undef PG8_WAIT_L
#undef PG8_BAR
#undef PG8_SCHED
}
}

constexpr int NWAVES = 8, NTHREADS = NWAVES * 64;
constexpr size_t MiB = 1u << 20;
constexpr size_t WS_CTL = 0, CTL_ZERO_BYTES = 1 * MiB;
constexpr size_t WS_COS = 1 * MiB, WS_SIN = 2 * MiB;
constexpr size_t WS_ASSQ = 3 * MiB;
constexpr size_t WS_TOKE = 4 * MiB, WS_TOKW = 5 * MiB, WS_TOKR = 6 * MiB;
constexpr size_t WS_CNT = 7 * MiB;
constexpr size_t WS_SDST = 8 * MiB, WS_SW = 9 * MiB, WS_SRS = 10 * MiB;
constexpr size_t WS_TILEE = 11 * MiB;
constexpr size_t WS_WR = 12 * MiB;
constexpr size_t WS_DECT = 14 * MiB;
constexpr size_t WS_DS = 16 * MiB;
constexpr size_t WS_WIN = 64 * MiB, WS_WOUT = 84 * MiB, WS_WGU = 92 * MiB, WS_WD = 348 * MiB;
constexpr size_t WS_XN = 476 * MiB;
constexpr size_t WS_PROJ = 540 * MiB;
constexpr size_t WS_ARAW = 692 * MiB;
constexpr size_t WS_MIX = 724 * MiB;
constexpr int XN2_P = 2176;
constexpr size_t WS_XN2 = 756 * MiB;
constexpr size_t WS_HID = 820 * MiB;
constexpr size_t WS_SIN_ST = 900 * MiB;
constexpr size_t WS_OF = 932 * MiB;
constexpr size_t WS_H = 476 * MiB;
constexpr size_t WS_XS = 540 * MiB;
constexpr size_t WS_Y = 640 * MiB;
constexpr size_t WS_END = 996 * MiB;
constexpr int CW_CMAX_IN = 16384, CW_CMAX_OUT = 16384 + 4864;
constexpr size_t WS_SAX = 15 * MiB, WS_SAM = 15 * MiB + 65536;
constexpr int CW_BAR = 4096;
constexpr int RING_BYTES = 131072, LDSCTL_OFF = RING_BYTES, MISC_OFF = LDSCTL_OFF + 320, TILEE_OFF = MISC_OFF + 128;
constexpr int LDS_BYTES = 147456;

#define GAS __attribute__((address_space(1)))
#define LAS __attribute__((address_space(3)))
typedef unsigned short bf16;
typedef float f32x4 __attribute__((ext_vector_type(4)));
typedef float f32x16 __attribute__((ext_vector_type(16)));
typedef short bf16x8 __attribute__((ext_vector_type(8)));
typedef short s16x4 __attribute__((ext_vector_type(4)));
typedef unsigned u32x4 __attribute__((ext_vector_type(4)));
typedef unsigned u32x2 __attribute__((ext_vector_type(2)));
#define LDS_WAIT() asm volatile("s_waitcnt lgkmcnt(0)" ::: "memory")
#define VM_WAIT() asm volatile("s_waitcnt vmcnt(0)" ::: "memory")
#define SBAR() __builtin_amdgcn_sched_barrier(0)
__device__ __forceinline__ unsigned f2bf(float f) { unsigned u = __builtin_bit_cast(unsigned, f); return (u + 0x7fffu + ((u >> 16) & 1u)) >> 16; }
__device__ __forceinline__ unsigned pk2(float lo, float hi) { return f2bf(lo) | (f2bf(hi) << 16); }
__device__ __forceinline__ float bflo(unsigned w) { return __builtin_bit_cast(float, w << 16); }
__device__ __forceinline__ float bfhi(unsigned w) { return __builtin_bit_cast(float, w & 0xffff0000u); }
#define WV_DPP(v, ctrl, rmask) __builtin_bit_cast(float, __builtin_amdgcn_update_dpp(0, __builtin_bit_cast(int, v), ctrl, rmask, 0xF, false))
__device__ __forceinline__ float wave_max(float v) {
    v = fmaxf(v, WV_DPP(v, 0x111, 0xF)); v = fmaxf(v, WV_DPP(v, 0x112, 0xF)); v = fmaxf(v, WV_DPP(v, 0x114, 0xF)); v = fmaxf(v, WV_DPP(v, 0x118, 0xF));
    v = fmaxf(v, WV_DPP(v, 0x142, 0xA)); v = fmaxf(v, WV_DPP(v, 0x143, 0xC));
    return __builtin_bit_cast(float, __builtin_amdgcn_readlane(__builtin_bit_cast(int, v), 63));
}
__device__ __forceinline__ float wave_sum(float v) {
    v += WV_DPP(v, 0x111, 0xF); v += WV_DPP(v, 0x112, 0xF); v += WV_DPP(v, 0x114, 0xF); v += WV_DPP(v, 0x118, 0xF);
    v += WV_DPP(v, 0x142, 0xA); v += WV_DPP(v, 0x143, 0xC);
    return __builtin_bit_cast(float, __builtin_amdgcn_readlane(__builtin_bit_cast(int, v), 63));
}

#define XB_TMO      128
#define XB_XCNT(j)  (256  + 64 * (j))
#define XB_XSUB(j)  (1280 + 64 * (j))
#define XB_XGEN(j)  (2304 + 64 * (j))
#define XB_TOP      3328
#define XB_TOPGEN   3392
#define XCD_BAR_WORDS 3456
#define XB_SPIN_CAP (1u << 18)
__device__ __forceinline__ unsigned xb_ld(unsigned* p)              { return __hip_atomic_load(p, __ATOMIC_RELAXED, __HIP_MEMORY_SCOPE_AGENT); }
__device__ __forceinline__ unsigned xb_add(unsigned* p, unsigned v) { return __hip_atomic_fetch_add(p, v, __ATOMIC_RELAXED, __HIP_MEMORY_SCOPE_AGENT); }
__device__ __forceinline__ unsigned xb_xcc_id() { return (unsigned)__builtin_amdgcn_s_getreg((3 << 11) | 20) & 0xFu; }
#define XB_SPIN(cond, bar) do { unsigned _sp = 0; while (cond) { __builtin_amdgcn_s_sleep(1); \
    if ((++_sp & 255u) == 0u) { if (xb_ld(&(bar)[XB_TMO])) break; if (_sp > XB_SPIN_CAP) { atomicAdd(&(bar)[XB_TMO], 1u); break; } } } } while (0)
struct XcdBarrier { unsigned* bar; unsigned x; volatile LAS unsigned* st; };
__device__ __forceinline__ XcdBarrier xcd_barrier_post(unsigned* bar, volatile LAS unsigned* st) {
    XcdBarrier b; b.bar = bar; b.x = xb_xcc_id(); b.st = st;
    if (threadIdx.x == 0) (void)xb_add(&bar[XB_XCNT(b.x)], 1u);
    return b;
}
__device__ __forceinline__ void xcd_barrier_complete(unsigned* bar, unsigned x, unsigned& nloc, unsigned& nx) {
    const unsigned G = gridDim.x * gridDim.y * gridDim.z;
    unsigned sum, cnt, mine, sp = 0u;
    for (;;) {
        sum = 0u; cnt = 0u; mine = 0u;
#pragma unroll
        for (unsigned j = 0; j < 16; ++j) { const unsigned c = xb_ld(&bar[XB_XCNT(j)]); sum += c; cnt += (c > 0u) ? 1u : 0u; mine = (j == x) ? c : mine; }
        if (sum == G) break;
        __builtin_amdgcn_s_sleep(1);
        if ((++sp & 255u) == 0u) { if (xb_ld(&bar[XB_TMO])) break; if (sp > XB_SPIN_CAP) { atomicAdd(&bar[XB_TMO], 1u); break; } }
    }
    nloc = mine > 0u ? mine : 1u; nx = cnt > 0u ? cnt : 1u;
}
__device__ __forceinline__ void xcd_barrier(const XcdBarrier& b) {
    asm volatile("s_waitcnt vmcnt(0)" ::: "memory");
    __syncthreads();
    if (threadIdx.x == 0) {
        unsigned* bar = b.bar;
        __builtin_amdgcn_s_waitcnt(0);
        unsigned nloc = b.st[0], nx = b.st[1];
        if (nloc == 0u) { xcd_barrier_complete(bar, b.x, nloc, nx); b.st[0] = nloc; b.st[1] = nx; }
        const unsigned old = xb_add(&bar[XB_XSUB(b.x)], 1u);
        const unsigned gen = old / nloc;
        if (old + 1u == (gen + 1u) * nloc) {
            __builtin_amdgcn_fence(__ATOMIC_RELEASE, "agent");
            asm volatile("s_waitcnt vmcnt(0)" ::: "memory");
            const unsigned og = xb_add(&bar[XB_TOP], 1u);
            const unsigned tg = og / nx;
            if (og + 1u == (tg + 1u) * nx) xb_add(&bar[XB_TOPGEN], 1u);
            else XB_SPIN(xb_ld(&bar[XB_TOPGEN]) == tg, bar);
            __builtin_amdgcn_fence(__ATOMIC_ACQUIRE, "agent");
            xb_add(&bar[XB_XGEN(b.x)], 1u);
            asm volatile("s_waitcnt vmcnt(0)" ::: "memory");
        } else {
            XB_SPIN(xb_ld(&bar[XB_XGEN(b.x)]) == gen, bar);
            __builtin_amdgcn_fence(__ATOMIC_ACQUIRE, "agent");
            asm volatile("s_waitcnt vmcnt(0)" ::: "memory");
        }
    }
    __syncthreads();
}

struct Args { const float* in[21]; float* out; unsigned char* ws; };
enum { I_X = 0, I_LN1, I_WIN, I_QNW, I_KNW, I_SINK, I_ANW, I_UPF, I_BF, I_UPB, I_BB, I_GNW, I_WOUT, I_LN2, I_WG, I_BG, I_WR, I_BR, I_WGE, I_WUE, I_WDE };

__device__ __forceinline__ unsigned pk4_i8(float a, float b, float c, float d) { const int i0 = __float2int_rn(a), i1 = __float2int_rn(b), i2 = __float2int_rn(c), i3 = __float2int_rn(d); return (unsigned)(i0 & 0xff) | ((unsigned)(i1 & 0xff) << 8) | ((unsigned)(i2 & 0xff) << 16) | ((unsigned)i3 << 24); }
struct TItem { const float* W; unsigned char* WT; const float* colmax; size_t dst_row0; int ldn, k0, n0, ldkb; float scale; };
__device__ __forceinline__ void titem_load(const TItem& t, f32x4 (&v)[16], int lane) {
    const int kr = lane >> 3, n4 = (lane & 7) * 4;
#pragma unroll
    for (int i = 0; i < 16; ++i) v[i] = __builtin_nontemporal_load((const GAS f32x4*)(t.W + (size_t)(t.k0 + 8 * i + kr) * t.ldn + t.n0 + n4));
}
__device__ __forceinline__ void titem_store_i8(const TItem& t, const f32x4 (&v)[16], LAS float* scr, int lane, const float (&scale_n)[4]) {
    const int kr = lane >> 3, q = lane & 7, nj = lane >> 3, p = lane & 7;
#pragma unroll
    for (int i = 0; i < 16; ++i) *(LAS f32x4*)(scr + (8 * i + kr) * 32 + 4 * (q ^ (i >> 1))) = v[i];
    LDS_WAIT(); asm volatile("" ::: "memory");
#pragma unroll
    for (int itr = 0; itr < 4; ++itr) { const int n = 8 * itr + nj; const LAS float* s = scr + (2 * p) * 256 + 4 * ((n >> 2) ^ p) + (n & 3); float f[16]; const float scale = scale_n[itr];
#pragma unroll
        for (int i = 0; i < 16; ++i) f[i] = s[(i >> 3) * 256 + (i & 7) * 32] * scale;
        u32x4 o; o.x = pk4_i8(f[0], f[1], f[2], f[3]); o.y = pk4_i8(f[4], f[5], f[6], f[7]); o.z = pk4_i8(f[8], f[9], f[10], f[11]); o.w = pk4_i8(f[12], f[13], f[14], f[15]);
        const size_t dr = t.dst_row0 + n;
        *(GAS u32x4*)(t.WT + dr * (size_t)t.ldkb + t.k0 + 16 * p) = o; }
    LDS_WAIT(); asm volatile("" ::: "memory");
}
template <int CLS> __device__ __forceinline__ TItem titem_make(const Args& a, int r) {
    unsigned char* ws = a.ws; TItem t; t.colmax = nullptr; t.scale = pg8::WSCALE;
    if (CLS == 0) { const int up = r >= 32 * 512; if (up) r -= 32 * 512; const int e = r >> 9, rr = r & 511, kb = rr >> 5, nb = rr & 31, n0 = nb * 32;
        t.W = a.in[up ? I_WUE : I_WGE] + (size_t)e * DM * DFF; t.ldn = DFF; t.k0 = kb * 128; t.n0 = n0; t.WT = ws + WS_WGU + (size_t)e * 2048 * DM; t.dst_row0 = (size_t)((n0 >> 7) * 256 + (n0 & 127) + up * 128); t.ldkb = -DM; }
    else if (CLS == 1) { const int e = r >> 9, rr = r & 511, kb = rr >> 6, nb = rr & 63;
        t.W = a.in[I_WDE] + (size_t)e * DFF * DM; t.ldn = DM; t.k0 = kb * 128; t.n0 = nb * 32; t.WT = ws + WS_WD + (size_t)e * DM * DFF; t.dst_row0 = (size_t)nb * 32; t.ldkb = -DFF; }
    else { t.scale = 1.f;
        if (r < 16 * 145) { const int kb = r / 145, nb = r % 145; t.W = a.in[I_WIN]; t.ldn = IN_W; t.k0 = kb * 128; t.n0 = nb * 32; t.WT = ws + WS_WIN; t.dst_row0 = (size_t)nb * 32; t.ldkb = DM; t.colmax = (const float*)(ws + WS_CTL) + CW_CMAX_IN; }
        else { r -= 16 * 145; const int kb = r >> 6, nb = r & 63; t.W = a.in[I_WOUT]; t.ldn = DM; t.k0 = kb * 128; t.n0 = nb * 32; t.WT = ws + WS_WOUT; t.dst_row0 = (size_t)nb * 32; t.ldkb = DM; t.colmax = (const float*)(ws + WS_CTL) + CW_CMAX_OUT; } }
    return t;
}
template <int CLS> __device__ __forceinline__ void titem_run(const Args& a, int it0, int nitems, int gw, int NGW, LAS float* scr, int lane) {
    static_assert(CLS != 2, "the int8 items go through p0_strip");
    const int kr = lane >> 3, q = lane & 7, nj = lane >> 3, p = lane & 7;
#pragma unroll 1
    for (int it = gw; it < nitems; it += NGW) { const TItem t = titem_make<CLS>(a, it0 + it);
        const float* src = t.W + (size_t)(t.k0 + kr) * t.ldn + t.n0;
#pragma unroll
        for (int i = 0; i < 16; ++i) __builtin_amdgcn_global_load_lds((const unsigned*)(src + (size_t)(8 * i) * t.ldn + 4 * (q ^ (i >> 1))), (LAS unsigned*)(scr + (8 * i) * 32), 16, 0, 2);
        asm volatile("s_waitcnt vmcnt(0)" ::: "memory");
        const float scale = t.scale;
#pragma unroll
        for (int itr = 0; itr < 4; ++itr) { const int n = 8 * itr + nj; const LAS float* s = scr + (2 * p) * 256 + 4 * ((n >> 2) ^ p) + (n & 3); float f[16];
#pragma unroll
            for (int i = 0; i < 16; ++i) f[i] = s[(i >> 3) * 256 + (i & 7) * 32] * scale;
            u32x4 o; o.x = pg8::pk4_fp8(f[0], f[1], f[2], f[3]); o.y = pg8::pk4_fp8(f[4], f[5], f[6], f[7]); o.z = pg8::pk4_fp8(f[8], f[9], f[10], f[11]); o.w = pg8::pk4_fp8(f[12], f[13], f[14], f[15]);
            size_t dr = t.dst_row0 + n;
            if (CLS == 1) { const int cl0 = (int)(t.dst_row0 & 255) + 8 * itr; dr = (t.dst_row0 & ~(size_t)255) + 128 * ((cl0 >> 3) & 1) + 32 * (cl0 >> 6) + 8 * ((cl0 >> 4) & 3) + nj; }
            unsigned char* dp = t.ldkb > 0 ? t.WT + dr * (size_t)t.ldkb + t.k0 + 16 * p : t.WT + (dr >> 8) * (size_t)(256 * -t.ldkb) + (size_t)(t.k0 >> 7) * 32768 + (dr & 255) * 128 + 16 * p;
            __builtin_nontemporal_store(o, (GAS u32x4*)dp); }
        LDS_WAIT(); asm volatile("" ::: "memory"); }
}
__device__ __forceinline__ void p0_strip(const Args& a, int strip, LAS float* scr, LAS float* cmw, int wave, int lane) {
    unsigned char* ws = a.ws; const bool o = strip >= 145; const int nb = o ? strip - 145 : strip, ldn = o ? DM : IN_W, n0 = nb * 32;
    const float* W = a.in[o ? I_WOUT : I_WIN]; float* cm = (float*)(ws + WS_CTL) + (o ? CW_CMAX_OUT : CW_CMAX_IN);
    const int n4 = (lane & 7) * 4;
    TItem t0; t0.W = W; t0.ldn = ldn; t0.n0 = n0; t0.WT = ws + (o ? WS_WOUT : WS_WIN); t0.dst_row0 = (size_t)n0; t0.ldkb = DM; t0.colmax = nullptr; t0.scale = 1.f; t0.k0 = (2 * wave) * 128;
    TItem t1 = t0; t1.k0 = (2 * wave + 1) * 128;
    f32x4 v0[16], v1[16]; titem_load(t0, v0, lane); titem_load(t1, v1, lane);
    f32x4 m = {0.f, 0.f, 0.f, 0.f};
#pragma unroll
    for (int i = 0; i < 16; ++i) { m.x = fmaxf(m.x, fmaxf(fabsf(v0[i].x), fabsf(v1[i].x))); m.y = fmaxf(m.y, fmaxf(fabsf(v0[i].y), fabsf(v1[i].y))); m.z = fmaxf(m.z, fmaxf(fabsf(v0[i].z), fabsf(v1[i].z))); m.w = fmaxf(m.w, fmaxf(fabsf(v0[i].w), fabsf(v1[i].w))); }
#pragma unroll
    for (int s = 8; s < 64; s <<= 1) { m.x = fmaxf(m.x, __shfl_xor(m.x, s)); m.y = fmaxf(m.y, __shfl_xor(m.y, s)); m.z = fmaxf(m.z, __shfl_xor(m.z, s)); m.w = fmaxf(m.w, __shfl_xor(m.w, s)); }
    if (lane < 8) *(LAS f32x4*)(cmw + wave * 32 + n4) = m;
    __syncthreads();
    float cmn = 0.f;
#pragma unroll
    for (int w = 0; w < 8; ++w) cmn = fmaxf(cmn, cmw[w * 32 + (lane & 31)]);
    if (wave == 0 && lane < 32) cm[n0 + lane] = cmn;
    float scale_n[4];
#pragma unroll
    for (int itr = 0; itr < 4; ++itr) { const float c = __shfl(cmn, 8 * itr + (lane >> 3)); scale_n[itr] = c > 0.f ? 127.f / c : 0.f; }
    titem_store_i8(t0, v0, scr, lane, scale_n);
    titem_store_i8(t1, v1, scr, lane, scale_n);
    __syncthreads();
}
__device__ __forceinline__ void p0_prologue(const Args& a, LAS unsigned char* lds, int wave, int lane, int G) {
    unsigned char* ws = a.ws;
    LAS float* scr = (LAS float*)(lds + wave * 16384);
    const int gw = blockIdx.x * NWAVES + wave, NGW = G * NWAVES;
    const int gt = blockIdx.x * NTHREADS + threadIdx.x, NGT = G * NTHREADS;
    constexpr int NSTRIP_IN = 145;
    { LAS float* cmw = (LAS float*)(lds + TILEE_OFF + 1024);
      for (int s = blockIdx.x; s < NSTRIP_IN; s += G) p0_strip(a, s, scr, cmw, wave, lane); }
    { GAS u32x4* z = (GAS u32x4*)(ws + WS_WIN + (size_t)IN_W * DM); const int n16 = (PROJ_LD - IN_W) * DM / 16;
      for (int i = gt; i < n16; i += NGT) z[i] = (u32x4){0u, 0u, 0u, 0u}; }
    { bf16* wr = (bf16*)(ws + WS_WR);
      for (int i = gt; i < 64 * DM; i += NGT) { const int n = i >> 11, k = i & 2047; float v = 0.f;
          if (n < 4) v = a.in[I_WG][k * 4 + n]; else if (n < 36) v = a.in[I_WR][k * 32 + (n - 4)];
          wr[i] = (bf16)f2bf(v); } }
    { float* cs = (float*)(ws + WS_COS); float* sn = (float*)(ws + WS_SIN);
      for (int i = gt; i < S_ * 16; i += NGT) { const int pos = i >> 4, f = i & 15; double inv;
          switch (f) { case 0: inv = 1.0; break; case 1: inv = 0.4403666026717805; break; case 2: inv = 0.1939227447486858; break; case 3: inv = 0.08539710028576561; break;
              case 4: inv = 0.03760603093086394; break; case 5: inv = 0.016560440080994443; break; case 6: inv = 0.007292664737217109; break; case 7: inv = 0.0032114459947525913; break;
              case 8: inv = 0.0014142135623730955; break; case 9: inv = 0.0006227724219145962; break; case 10: inv = 0.00027424817567620724; break; case 11: inv = 0.00012076973741146502; break;
              case 12: inv = 5.318295896944988e-05; break; case 13: inv = 2.3419998961409345e-05; break; case 14: inv = 1.0313385377212461e-05; break; default: inv = 4.541670480607871e-06; break; }
          const double rev = (double)pos * inv * 0.15915494309189535; const float fr = (float)(rev - rint(rev)) * 6.283185307179586f;
          cs[i] = cosf(fr); sn[i] = sinf(fr); } }
    { const float* x = a.in[I_X]; const float* lw = a.in[I_LN1]; unsigned char* xn = ws + WS_XN; float* sax = (float*)(ws + WS_SAX);
      f32x4 w[8];
#pragma unroll
      for (int j = 0; j < 8; ++j) w[j] = *((const f32x4*)lw + lane + 64 * j);
      f32x4 v[8];
      const bool wgt = (G == 256); const int bx = blockIdx.x;
      const int NSLOT = wgt ? NWAVES * (NSTRIP_IN + 2 * (256 - NSTRIP_IN)) : NGW;
      const int slot0 = wgt ? (bx < NSTRIP_IN ? bx * NWAVES + wave : NSTRIP_IN * NWAVES + (bx - NSTRIP_IN) * 2 * NWAVES + wave) : gw;
      const int nsl = (wgt && bx >= NSTRIP_IN) ? 2 : 1;
      for (int sl = 0; sl < nsl; ++sl) {
      const int rw = slot0 + sl * NWAVES, RNW = NSLOT;
      if (rw >= 0 && rw < S_) { const GAS f32x4* xr = (const GAS f32x4*)(x + (size_t)rw * DM) + lane;
#pragma unroll
          for (int j = 0; j < 8; ++j) v[j] = __builtin_nontemporal_load(xr + 64 * j); }
#pragma unroll 1
      for (int m = rw; m >= 0 && m < S_; m += RNW) { const int mn = (m + RNW < S_) ? m + RNW : m; const GAS f32x4* xr = (const GAS f32x4*)(x + (size_t)mn * DM) + lane;
          f32x4 vn[8]; float s = 0.f;
#pragma unroll
          for (int j = 0; j < 8; ++j) vn[j] = __builtin_nontemporal_load(xr + 64 * j);
#pragma unroll
          for (int j = 0; j < 8; ++j) s += (v[j].x * v[j].x + v[j].y * v[j].y) + (v[j].z * v[j].z + v[j].w * v[j].w);
          const float rstd = 1.f / sqrtf(wave_sum(s) * (1.f / DM) + EPS_); float mx = 0.f;
#pragma unroll
          for (int j = 0; j < 8; ++j) { v[j] = v[j] * rstd * w[j]; mx = fmaxf(fmaxf(mx, fmaxf(fabsf(v[j].x), fabsf(v[j].y))), fmaxf(fabsf(v[j].z), fabsf(v[j].w))); }
          mx = wave_max(mx); const float inv = mx > 0.f ? 127.f / mx : 0.f;
          if (lane == 0) sax[m] = mx * (1.f / 127.f);
          GAS unsigned* o4 = (GAS unsigned*)(xn + (size_t)m * DM) + lane;
#pragma unroll
          for (int j = 0; j < 8; ++j) o4[64 * j] = pk4_i8(v[j].x * inv, v[j].y * inv, v[j].z * inv, v[j].w * inv);
#pragma unroll
          for (int j = 0; j < 8; ++j) v[j] = vn[j]; } } }
}

__device__ __forceinline__ void qk_norm_rope(const Args& a, int wave, int lane, int G) {
    bf16* proj = (bf16*)(a.ws + WS_PROJ); const float* cs = (const float*)(a.ws + WS_COS); const float* sn = (const float*)(a.ws + WS_SIN);
    const int gw = blockIdx.x * NWAVES + wave, NGW = G * NWAVES; const int l16 = lane & 15, sub = lane >> 4;
    float wq[8], wk[8];
#pragma unroll
    for (int e = 0; e < 8; ++e) { wq[e] = a.in[I_QNW][8 * l16 + e]; wk[e] = a.in[I_KNW][8 * l16 + e]; }
    for (int rs = gw * 4 + sub; rs < S_ * 2; rs += NGW * 4) {
        const int t = rs >> 1, j = 8 + (rs & 1); const int col0 = C_AK + (j - 8) * 128 + 8 * l16;
        GAS u32x4* p = (GAS u32x4*)(proj + (size_t)t * PROJ_LD + col0); const u32x4 raw = *p;
        float y[8]; y[0] = bflo(raw.x); y[1] = bfhi(raw.x); y[2] = bflo(raw.y); y[3] = bfhi(raw.y); y[4] = bflo(raw.z); y[5] = bfhi(raw.z); y[6] = bflo(raw.w); y[7] = bfhi(raw.w);
        float s = 0.f;
#pragma unroll
        for (int e = 0; e < 8; ++e) s += y[e] * y[e];
        s += __shfl_xor(s, 1); s += __shfl_xor(s, 2); s += __shfl_xor(s, 4); s += __shfl_xor(s, 8);
        const float rstd = 1.f / sqrtf(s * (1.f / 128.f) + EPS_);
#pragma unroll
        for (int e = 0; e < 8; ++e) y[e] = y[e] * rstd * (j < 8 ? wq[e] : wk[e]);
        float pr[8];
#pragma unroll
        for (int e = 0; e < 8; ++e) pr[e] = __shfl_xor(y[e], 2);
        if (l16 < 4) { const int fi = 8 * (l16 & 1); const float sg = (l16 < 2) ? -1.f : 1.f;
#pragma unroll
            for (int e = 0; e < 8; ++e) { const float c = cs[t * 16 + fi + e], sv = sn[t * 16 + fi + e]; y[e] = y[e] * c + sg * pr[e] * sv; } }
        u32x4 o; o.x = pk2(y[0], y[1]); o.y = pk2(y[2], y[3]); o.z = pk2(y[4], y[5]); o.w = pk2(y[6], y[7]);
        *p = o;
    }
}

#define KSWZ(row, colB) ((row) * 256 + ((colB) ^ (((row) & 7) << 4)))
__device__ __forceinline__ int crow(int r, int hi) { return (r & 3) + 8 * (r >> 2) + 4 * hi; }
__device__ __forceinline__ unsigned cvtpk(float lo, float hi) { unsigned r; asm volatile("v_cvt_pk_bf16_f32 %0, %1, %2" : "=v"(r) : "v"(lo), "v"(hi)); return r; }
__device__ __forceinline__ int v_st(int k, int c) { const int kk = (k & ~0xC) | ((k & 4) << 1) | ((k & 8) >> 1); return ((kk >> 3) * 4 + (c >> 5)) * 512 + ((kk & 7) * 32 + (c & 31)) * 2; }
__device__ __forceinline__ int v_rd_base(int lane) { return ((lane & 3) << 3) | (((lane >> 2) & 3) << 6) | (((lane >> 4) & 1) << 5) | (((lane >> 5) & 1) << 8); }
constexpr int v_rd_off(int d0, int ks, int half) { return d0 * 512 + ks * 4096 + half * 2048; }
template <int OFF> __device__ __forceinline__ s16x4 tr_read(int vb) { s16x4 r; asm volatile("ds_read_b64_tr_b16 %0, %1 offset:%2" : "=&v"(r) : "v"(vb), "i"(OFF) : "memory"); return r; }
template <int D0> __device__ __forceinline__ void pv_one(f32x16& od, int vb, bf16x8 pa0, bf16x8 pa1, bf16x8 pa2, bf16x8 pa3) {
    const s16x4 l0 = tr_read<v_rd_off(D0, 0, 0)>(vb), h0 = tr_read<v_rd_off(D0, 0, 1)>(vb), l1 = tr_read<v_rd_off(D0, 1, 0)>(vb), h1 = tr_read<v_rd_off(D0, 1, 1)>(vb);
    const s16x4 l2 = tr_read<v_rd_off(D0, 2, 0)>(vb), h2 = tr_read<v_rd_off(D0, 2, 1)>(vb), l3 = tr_read<v_rd_off(D0, 3, 0)>(vb), h3 = tr_read<v_rd_off(D0, 3, 1)>(vb);
    asm volatile("s_waitcnt lgkmcnt(0)" ::: "memory"); SBAR();
#define PKV(L, H) (bf16x8){L[0], L[1], L[2], L[3], H[0], H[1], H[2], H[3]}
    od = __builtin_amdgcn_mfma_f32_32x32x16_bf16(pa0, PKV(l0, h0), od, 0, 0, 0);
    od = __builtin_amdgcn_mfma_f32_32x32x16_bf16(pa1, PKV(l1, h1), od, 0, 0, 0);
    od = __builtin_amdgcn_mfma_f32_32x32x16_bf16(pa2, PKV(l2, h2), od, 0, 0, 0);
    od = __builtin_amdgcn_mfma_f32_32x32x16_bf16(pa3, PKV(l3, h3), od, 0, 0, 0);
#undef PKV
}
__device__ __forceinline__ void attn_unit(const Args& a, unsigned char* lds, int tb, int g) {
    constexpr float SCALE = 0.088388347648318440f, C = SCALE * 1.4426950408889634f, NEG = -1e30f;
    const int tid = opaque_tid(), wid = __builtin_amdgcn_readfirstlane(tid >> 6), lane = tid & 63, r32 = lane & 31, hi = lane >> 5;
    const bf16* proj = (const bf16*)(a.ws + WS_PROJ); bf16* araw = (bf16*)(a.ws + WS_ARAW); float* assq = (float*)(a.ws + WS_ASSQ);
    const int t0 = tb * 64, hq = 4 * g + (wid >> 1), qrow = t0 + 32 * (wid & 1) + r32;
    bf16* K_lds = (bf16*)lds; bf16* V_lds = (bf16*)(lds + 16384);
    float* wsf = (float*)(lds + 32768) + wid * 64; float* al_l = wsf; float* li_l = wsf + 32;
    bf16* stg = (bf16*)(lds + 36864) + wid * 4096;
    bf16x8 qr[8];
    { const bf16* Qw = proj + (size_t)qrow * PROJ_LD + C_AQ + hq * 128 + hi * 8;
      u32x4 raw[8];
#pragma unroll
      for (int d0 = 0; d0 < 8; ++d0) raw[d0] = *(const u32x4*)(Qw + d0 * 16);
      float qf[8][8]; float ss = 0.f;
#pragma unroll
      for (int d0 = 0; d0 < 8; ++d0) { qf[d0][0] = bflo(raw[d0].x); qf[d0][1] = bfhi(raw[d0].x); qf[d0][2] = bflo(raw[d0].y); qf[d0][3] = bfhi(raw[d0].y); qf[d0][4] = bflo(raw[d0].z); qf[d0][5] = bfhi(raw[d0].z); qf[d0][6] = bflo(raw[d0].w); qf[d0][7] = bfhi(raw[d0].w);
#pragma unroll
          for (int e = 0; e < 8; ++e) ss += qf[d0][e] * qf[d0][e]; }
      { auto rr = __builtin_amdgcn_permlane32_swap(__float_as_uint(ss), __float_as_uint(ss), false, false); ss = __uint_as_float(rr[0]) + __uint_as_float(rr[1]); }
      const float rstd = 1.f / sqrtf(ss * (1.f / 128.f) + EPS_);
      const float* qnw = a.in[I_QNW] + hi * 8;
#pragma unroll
      for (int d0 = 0; d0 < 8; ++d0) { const f32x4 w0 = *(const f32x4*)(qnw + d0 * 16), w1 = *(const f32x4*)(qnw + d0 * 16 + 4);
          qf[d0][0] *= rstd * w0.x; qf[d0][1] *= rstd * w0.y; qf[d0][2] *= rstd * w0.z; qf[d0][3] *= rstd * w0.w; qf[d0][4] *= rstd * w1.x; qf[d0][5] *= rstd * w1.y; qf[d0][6] *= rstd * w1.z; qf[d0][7] *= rstd * w1.w; }
      { const float* cs = (const float*)(a.ws + WS_COS) + (size_t)qrow * 16 + hi * 8; const float* sn = (const float*)(a.ws + WS_SIN) + (size_t)qrow * 16 + hi * 8;
        const f32x4 c0 = *(const f32x4*)cs, c1 = *(const f32x4*)(cs + 4), s0 = *(const f32x4*)sn, s1 = *(const f32x4*)(sn + 4);
        const float cv[8] = {c0.x, c0.y, c0.z, c0.w, c1.x, c1.y, c1.z, c1.w}, sv[8] = {s0.x, s0.y, s0.z, s0.w, s1.x, s1.y, s1.z, s1.w};
#pragma unroll
        for (int e = 0; e < 8; ++e) { const float y1 = qf[0][e], y2 = qf[1][e]; qf[0][e] = y1 * cv[e] - y2 * sv[e]; qf[1][e] = y2 * cv[e] + y1 * sv[e]; } }
#pragma unroll
      for (int d0 = 0; d0 < 8; ++d0) { u32x4 w; w.x = pk2(qf[d0][0], qf[d0][1]); w.y = pk2(qf[d0][2], qf[d0][3]); w.z = pk2(qf[d0][4], qf[d0][5]); w.w = pk2(qf[d0][6], qf[d0][7]); qr[d0] = __builtin_bit_cast(bf16x8, w); } }
    float m_reg = a.in[I_SINK][hq] * (1.f / SCALE), l_reg = 1.f;
    f32x16 o[4]; o[0] = f32x16{}; o[1] = f32x16{}; o[2] = f32x16{}; o[3] = f32x16{};
    const int sr = tid >> 4, sc = (tid & 15) * 8, vst0 = v_st(sr, sc), vst1 = v_st(32 + sr, sc);
    const int vb0 = (int)(uintptr_t)V_lds + v_rd_base(lane);
    for (int j = 0; j < 5; ++j) {
        const int kt = t0 - 128 + 64 * j;
        if (kt < 0 || kt >= S_) continue;
        { const bf16* Kg = proj + (size_t)kt * PROJ_LD + C_AK + g * 128 + sc; const bf16* Vg = proj + (size_t)kt * PROJ_LD + C_AV + g * 128 + sc;
          const bf16x8 k0 = *(const bf16x8*)(Kg + (size_t)sr * PROJ_LD), k1 = *(const bf16x8*)(Kg + (size_t)(32 + sr) * PROJ_LD);
          const bf16x8 v0 = *(const bf16x8*)(Vg + (size_t)sr * PROJ_LD), v1 = *(const bf16x8*)(Vg + (size_t)(32 + sr) * PROJ_LD);
          *(bf16x8*)((char*)K_lds + KSWZ(sr, sc * 2)) = k0; *(bf16x8*)((char*)K_lds + KSWZ(32 + sr, sc * 2)) = k1;
          *(bf16x8*)((char*)V_lds + vst0) = v0; *(bf16x8*)((char*)V_lds + vst1) = v1; }
        __syncthreads();
        f32x16 p0 = f32x16{}, p1 = f32x16{};
#pragma unroll
        for (int d0 = 0; d0 < 8; ++d0) { const int cb = (d0 * 16 + hi * 8) * 2;
            const bf16x8 b0 = *(const bf16x8*)((const char*)K_lds + KSWZ(r32, cb));
            const bf16x8 b1 = *(const bf16x8*)((const char*)K_lds + KSWZ(32 + r32, cb));
            p0 = __builtin_amdgcn_mfma_f32_32x32x16_bf16(b0, qr[d0], p0, 0, 0, 0);
            p1 = __builtin_amdgcn_mfma_f32_32x32x16_bf16(b1, qr[d0], p1, 0, 0, 0); }
        if (j == 0 || j == 4) {
#pragma unroll
            for (int r = 0; r < 16; ++r) { const int rel = kt + crow(r, hi) - qrow; if (rel < -128 || rel > 128) p0[r] = NEG; if (rel + 32 < -128 || rel + 32 > 128) p1[r] = NEG; } }
        float pmax = p0[0];
#pragma unroll
        for (int r = 1; r < 16; ++r) pmax = fmaxf(pmax, p0[r]);
#pragma unroll
        for (int r = 0; r < 16; ++r) pmax = fmaxf(pmax, p1[r]);
        { auto rr = __builtin_amdgcn_permlane32_swap(__float_as_uint(pmax), __float_as_uint(pmax), false, false); pmax = fmaxf(__uint_as_float(rr[0]), __uint_as_float(rr[1])); }
        const float mn = fmaxf(m_reg, pmax), alpha = __builtin_amdgcn_exp2f((m_reg - mn) * C); m_reg = mn;
        const float mnC = -mn * C;
#pragma unroll
        for (int r = 0; r < 16; ++r) { p0[r] = __builtin_amdgcn_exp2f(fmaf(p0[r], C, mnC)); p1[r] = __builtin_amdgcn_exp2f(fmaf(p1[r], C, mnC)); }
        float ps = 0.f;
#pragma unroll
        for (int r = 0; r < 16; ++r) ps += p0[r] + p1[r];
        { auto rr = __builtin_amdgcn_permlane32_swap(__float_as_uint(ps), __float_as_uint(ps), false, false); ps = __uint_as_float(rr[0]) + __uint_as_float(rr[1]); }
        l_reg = l_reg * alpha + ps;
        if (__any(alpha < 1.f)) { if (hi == 0) al_l[r32] = alpha; LDS_WAIT();
#pragma unroll
            for (int d = 0; d < 4; ++d)
#pragma unroll
                for (int r = 0; r < 16; ++r) o[d][r] *= al_l[crow(r, hi)]; }
        bf16x8 pa0, pa1, pa2, pa3;
#define PK4(P, BASE, OUT) do { unsigned a0 = cvtpk(P[BASE + 0], P[BASE + 1]), a1 = cvtpk(P[BASE + 2], P[BASE + 3]);   \
    unsigned b0 = cvtpk(P[BASE + 4], P[BASE + 5]), b1 = cvtpk(P[BASE + 6], P[BASE + 7]);                              \
    auto r0 = __builtin_amdgcn_permlane32_swap(a0, b0, false, false); auto r1 = __builtin_amdgcn_permlane32_swap(a1, b1, false, false); \
    u32x4 w = {r0[0], r1[0], r0[1], r1[1]}; OUT = *reinterpret_cast<bf16x8*>(&w); } while (0)
        PK4(p0, 0, pa0); PK4(p0, 8, pa1); PK4(p1, 0, pa2); PK4(p1, 8, pa3);
#undef PK4
        SBAR();
        pv_one<0>(o[0], vb0, pa0, pa1, pa2, pa3); pv_one<1>(o[1], vb0, pa0, pa1, pa2, pa3); pv_one<2>(o[2], vb0, pa0, pa1, pa2, pa3); pv_one<3>(o[3], vb0, pa0, pa1, pa2, pa3);
        __syncthreads();
    }
    if (hi == 0) li_l[r32] = l_reg; LDS_WAIT();
#pragma unroll
    for (int r = 0; r < 16; ++r) { const int orow = crow(r, hi); const float rl = __builtin_amdgcn_rcpf(li_l[orow]);
#pragma unroll
        for (int d0 = 0; d0 < 4; ++d0) stg[orow * 128 + d0 * 32 + r32] = (bf16)f2bf(o[d0][r] * rl); }
    LDS_WAIT();
#pragma unroll
    for (int i = 0; i < 8; ++i) { const int row = i * 4 + (lane >> 4), ch = lane & 15; const u32x4 v = *(const u32x4*)(stg + row * 128 + ch * 8);
        const int tok = t0 + 32 * (wid & 1) + row;
        *(u32x4*)(araw + (size_t)tok * 1024 + hq * 128 + ch * 8) = v;
        float s = bflo(v.x) * bflo(v.x) + bfhi(v.x) * bfhi(v.x) + bflo(v.y) * bflo(v.y) + bfhi(v.y) * bfhi(v.y) + bflo(v.z) * bflo(v.z) + bfhi(v.z) * bfhi(v.z) + bflo(v.w) * bflo(v.w) + bfhi(v.w) * bfhi(v.w);
        s += __shfl_xor(s, 1); s += __shfl_xor(s, 2); s += __shfl_xor(s, 4); s += __shfl_xor(s, 8);
        if (ch == 0) assq[tok * 8 + hq] = s; }
    __syncthreads();
}


constexpr int GL_BIAS = 0, GL_QD = 512, GL_KI = GL_QD + 17408, GL_KET = GL_KI + 17408, GL_VR = GL_KET + 18432, GL_ATT = GL_VR + 36864, GL_DEC = GL_ATT + 9216;
template <int OFF> __device__ __forceinline__ s16x4 tr_read_g(int vb) { s16x4 r; asm volatile("ds_read_b64_tr_b16 %0, %1 offset:%2" : "=&v"(r) : "v"(vb), "i"(OFF) : "memory"); return r; }
#define DPP_ADD(v, ctrl, rmask) v += __builtin_bit_cast(float, __builtin_amdgcn_update_dpp(0, __builtin_bit_cast(int, v), ctrl, rmask, 0xF, false))
template <int PASS> __device__ __forceinline__ void gla_unit(const Args& a, unsigned char* lds, int dir, int head, int sc) {
    const int tid = opaque_tid(), wid = __builtin_amdgcn_readfirstlane(tid >> 6), lane = tid & 63, r32 = lane & 31, hi = lane >> 5;
    const bf16* proj = (const bf16*)(a.ws + WS_PROJ);
    float* BIAS = (float*)(lds + GL_BIAS); float* DEC = (float*)(lds + GL_DEC);
    char* QD = (char*)(lds + GL_QD); char* KI = (char*)(lds + GL_KI); char* KET = (char*)(lds + GL_KET); char* VR = (char*)(lds + GL_VR); char* ATT = (char*)(lds + GL_ATT);
    const float* upg = a.in[dir ? I_UPB : I_UPF];
    if (tid < 128) BIAS[tid] = a.in[dir ? I_BB : I_BF][head * 128 + tid];
    bf16x8 Aup;
    { float u[8];
#pragma unroll
      for (int jj = 0; jj < 8; ++jj) u[jj] = (r32 < 16) ? upg[(8 * hi + jj) * 512 + head * 128 + 16 * wid + r32] : 0.f;
      u32x4 w; w.x = pk2(u[0], u[1]); w.y = pk2(u[2], u[3]); w.z = pk2(u[4], u[5]); w.w = pk2(u[6], u[7]); Aup = __builtin_bit_cast(bf16x8, w); }
    const int dh = dir * 4 + head;
    f32x16 St[4];
    if (PASS == 3) { const float* sin_st = (const float*)(a.ws + WS_SIN_ST) + ((size_t)dh * 32 + sc) * 32768;
#pragma unroll
        for (int db = 0; db < 4; ++db)
#pragma unroll
            for (int r = 0; r < 16; ++r) St[db][r] = sin_st[(32 * db + crow(r, hi)) * 256 + 32 * wid + r32];
    } else { St[0] = f32x16{}; St[1] = f32x16{}; St[2] = f32x16{}; St[3] = f32x16{}; }
    float bsum[8];
#pragma unroll
    for (int c = 0; c < 8; ++c) bsum[c] = 0.f;
    u32x4 rq[2], rk[2], rv[4], rl[2];
#define GLA_TOK(CI, ROW) (dir ? (S_ - 1 - (sc * 512 + (CI) * 64 + (ROW))) : (sc * 512 + (CI) * 64 + (ROW)))
#define GLA_LOAD(CI) do { \
        _Pragma("unroll") for (int i_ = 0; i_ < 2; ++i_) { const int c_ = tid + 512 * i_, row_ = c_ >> 4, ch_ = c_ & 15; const bf16* p_ = proj + (size_t)GLA_TOK(CI, row_) * PROJ_LD + head * 128 + ch_ * 8; \
            rk[i_] = *(const u32x4*)(p_ + C_GK); if (PASS == 3) rq[i_] = *(const u32x4*)(p_ + C_GQ); } \
        _Pragma("unroll") for (int i_ = 0; i_ < 4; ++i_) { const int c_ = tid + 512 * i_, row_ = c_ >> 5, ch_ = c_ & 31; rv[i_] = *(const u32x4*)(proj + (size_t)GLA_TOK(CI, row_) * PROJ_LD + C_GV + head * 256 + ch_ * 8); } \
        _Pragma("unroll") for (int b_ = 0; b_ < 2; ++b_) rl[b_] = *(const u32x4*)(proj + (size_t)GLA_TOK(CI, 32 * b_ + r32) * PROJ_LD + (dir ? C_LRB : C_LRF) + 8 * hi); } while (0)
    GLA_LOAD(0);
    const int vb = (int)(uintptr_t)VR + (8 * hi + ((lane & 15) >> 2)) * 576 + (32 * wid + 16 * ((lane >> 4) & 1) + 4 * (lane & 3)) * 2;
    __syncthreads();
#pragma unroll 1
    for (int ci = 0; ci < 8; ++ci) {
#pragma unroll
        for (int i = 0; i < 2; ++i) { const int c = tid + 512 * i, row = c >> 4, ch = c & 15; *(u32x4*)(KI + row * 272 + ch * 16) = rk[i]; if (PASS == 3) *(u32x4*)(QD + row * 272 + ch * 16) = rq[i]; }
#pragma unroll
        for (int i = 0; i < 4; ++i) { const int c = tid + 512 * i, row = c >> 5, ch = c & 31; *(u32x4*)(VR + row * 576 + ch * 16) = rv[i]; }
        const bf16x8 lrB0 = __builtin_bit_cast(bf16x8, rl[0]), lrB1 = __builtin_bit_cast(bf16x8, rl[1]);
        { const int cn = ci < 7 ? ci + 1 : 7; GLA_LOAD(cn); }
        __syncthreads();
        {
          f32x16 g0 = __builtin_amdgcn_mfma_f32_32x32x16_bf16(Aup, lrB0, f32x16{}, 0, 0, 0), g1 = __builtin_amdgcn_mfma_f32_32x32x16_bf16(Aup, lrB1, f32x16{}, 0, 0, 0);
          const f32x4 bia = *(const f32x4*)(BIAS + 16 * wid + 4 * hi), bib = *(const f32x4*)(BIAS + 16 * wid + 8 + 4 * hi);
          float b0[8], b1[8];
#pragma unroll
          for (int j = 0; j < 8; ++j) { const float bi = j < 4 ? bia[j & 3] : bib[j & 3];
              float x0 = g0[j] + bi, x1 = g1[j] + bi;
              x0 = (fminf(x0, 0.f) - __logf(1.f + __expf(-fabsf(x0)))) * (1.f / 16.f); x1 = (fminf(x1, 0.f) - __logf(1.f + __expf(-fabsf(x1)))) * (1.f / 16.f);
              DPP_ADD(x0, 0x111, 0xF); DPP_ADD(x0, 0x112, 0xF); DPP_ADD(x0, 0x114, 0xF); DPP_ADD(x0, 0x118, 0xF); DPP_ADD(x0, 0x142, 0xA);
              DPP_ADD(x1, 0x111, 0xF); DPP_ADD(x1, 0x112, 0xF); DPP_ADD(x1, 0x114, 0xF); DPP_ADD(x1, 0x118, 0xF); DPP_ADD(x1, 0x142, 0xA);
              const float t0a = __builtin_bit_cast(float, __builtin_amdgcn_readlane(__builtin_bit_cast(int, x0), 31)), t0b = __builtin_bit_cast(float, __builtin_amdgcn_readlane(__builtin_bit_cast(int, x0), 63));
              x1 += hi ? t0b : t0a;
              b0[j] = x0; b1[j] = x1; }
          float blast[8];
#pragma unroll
          for (int j = 0; j < 8; ++j) { const float la = __builtin_bit_cast(float, __builtin_amdgcn_readlane(__builtin_bit_cast(int, b1[j]), 31)), lb = __builtin_bit_cast(float, __builtin_amdgcn_readlane(__builtin_bit_cast(int, b1[j]), 63));
              blast[j] = hi ? lb : la; bsum[j] += blast[j]; }
          float dec[8];
#pragma unroll
          for (int j = 0; j < 8; ++j) dec[j] = __expf(blast[j]);
          if (r32 == 0) { *(f32x4*)(DEC + 16 * wid + 4 * hi) = (f32x4){dec[0], dec[1], dec[2], dec[3]}; *(f32x4*)(DEC + 16 * wid + 8 + 4 * hi) = (f32x4){dec[4], dec[5], dec[6], dec[7]}; }
#pragma unroll
          for (int blk = 0; blk < 2; ++blk) { const int tok = 32 * blk + r32; const float* bb = blk ? b1 : b0;
              char* kp = KI + tok * 272 + (16 * wid + 4 * hi) * 2; const u32x2 ka = *(const u32x2*)kp, kb = *(const u32x2*)(kp + 16);
              const float kf[8] = {bflo(ka.x), bfhi(ka.x), bflo(ka.y), bfhi(ka.y), bflo(kb.x), bfhi(kb.x), bflo(kb.y), bfhi(kb.y)};
              float ki[8];
#pragma unroll
              for (int j = 0; j < 8; ++j) ki[j] = kf[j] * __expf(-bb[j]);
              bf16* ket = (bf16*)KET + (16 * wid + 4 * hi) * 72 + tok;
#pragma unroll
              for (int j = 0; j < 8; ++j) ket[((j & 3) + 8 * (j >> 2)) * 72] = (bf16)f2bf(ki[j] * dec[j]);
              if (PASS == 3) {
                  u32x2 wa, wb; wa.x = pk2(ki[0], ki[1]); wa.y = pk2(ki[2], ki[3]); wb.x = pk2(ki[4], ki[5]); wb.y = pk2(ki[6], ki[7]);
                  *(u32x2*)kp = wa; *(u32x2*)(kp + 16) = wb;
                  char* qp = QD + tok * 272 + (16 * wid + 4 * hi) * 2; const u32x2 qa = *(const u32x2*)qp, qb = *(const u32x2*)(qp + 16);
                  const float qf[8] = {bflo(qa.x), bfhi(qa.x), bflo(qa.y), bfhi(qa.y), bflo(qb.x), bfhi(qb.x), bflo(qb.y), bfhi(qb.y)};
                  float qd[8];
#pragma unroll
                  for (int j = 0; j < 8; ++j) qd[j] = qf[j] * 0.088388347648318440f * __expf(bb[j]);
                  wa.x = pk2(qd[0], qd[1]); wa.y = pk2(qd[2], qd[3]); wb.x = pk2(qd[4], qd[5]); wb.y = pk2(qd[6], qd[7]);
                  *(u32x2*)qp = wa; *(u32x2*)(qp + 16) = wb; } }
        }
        __syncthreads();
        f32x16 oT[2]; oT[0] = f32x16{}; oT[1] = f32x16{};
        if (PASS == 3) {
#pragma unroll
            for (int e = 0; e < 2; ++e) { const int blk = 2 * wid + e, jb = blk >> 2, cb = blk & 3; const int l15 = lane & 15, l4 = lane >> 4;
                f32x4 acc = {0.f, 0.f, 0.f, 0.f};
                if (jb <= cb) {
#pragma unroll
                    for (int ks = 0; ks < 4; ++ks) { const bf16x8 A = *(const bf16x8*)(KI + (16 * jb + l15) * 272 + (8 * l4 + 32 * ks) * 2); const bf16x8 B = *(const bf16x8*)(QD + (16 * cb + l15) * 272 + (8 * l4 + 32 * ks) * 2);
                        acc = __builtin_amdgcn_mfma_f32_16x16x32_bf16(A, B, acc, 0, 0, 0); }
                    const int c = 16 * cb + l15, j0 = 16 * jb + 4 * l4;
#pragma unroll
                    for (int r = 0; r < 4; ++r) if (j0 + r > c) acc[r] = 0.f;
                }
                u32x2 w; w.x = pk2(acc[0], acc[1]); w.y = pk2(acc[2], acc[3]);
                *(u32x2*)(ATT + (16 * cb + l15) * 144 + (16 * jb + 4 * l4) * 2) = w; }
            __syncthreads();
        }
        bf16x8 Vf[4];
        { const s16x4 a0 = tr_read_g<0>(vb), c0 = tr_read_g<2304>(vb), a1 = tr_read_g<9216>(vb), c1 = tr_read_g<9216 + 2304>(vb);
          const s16x4 a2 = tr_read_g<18432>(vb), c2 = tr_read_g<18432 + 2304>(vb), a3 = tr_read_g<27648>(vb), c3 = tr_read_g<27648 + 2304>(vb);
          asm volatile("s_waitcnt lgkmcnt(0)" ::: "memory"); SBAR();
          Vf[0] = (bf16x8){a0[0], a0[1], a0[2], a0[3], c0[0], c0[1], c0[2], c0[3]}; Vf[1] = (bf16x8){a1[0], a1[1], a1[2], a1[3], c1[0], c1[1], c1[2], c1[3]};
          Vf[2] = (bf16x8){a2[0], a2[1], a2[2], a2[3], c2[0], c2[1], c2[2], c2[3]}; Vf[3] = (bf16x8){a3[0], a3[1], a3[2], a3[3], c3[0], c3[1], c3[2], c3[3]}; }
        if (PASS == 3) {
#pragma unroll
            for (int cb2 = 0; cb2 < 2; ++cb2) {
#pragma unroll
                for (int ks = 0; ks < 4; ++ks) { if (cb2 == 0 && ks >= 2) continue;
                    const bf16x8 B = *(const bf16x8*)(ATT + (32 * cb2 + r32) * 144 + (16 * ks + 8 * hi) * 2);
                    oT[cb2] = __builtin_amdgcn_mfma_f32_32x32x16_bf16(Vf[ks], B, oT[cb2], 0, 0, 0); }
#pragma unroll
                for (int db = 0; db < 4; ++db)
#pragma unroll
                    for (int s = 0; s < 2; ++s) { u32x4 sw; sw.x = cvtpk(St[db][8 * s + 0], St[db][8 * s + 1]); sw.y = cvtpk(St[db][8 * s + 2], St[db][8 * s + 3]); sw.z = cvtpk(St[db][8 * s + 4], St[db][8 * s + 5]); sw.w = cvtpk(St[db][8 * s + 6], St[db][8 * s + 7]);
                        const char* qp = QD + (32 * cb2 + r32) * 272 + (32 * db + 16 * s + 4 * hi) * 2; const u32x2 blo = *(const u32x2*)qp, bhi2 = *(const u32x2*)(qp + 16);
                        const u32x4 bw = {blo.x, blo.y, bhi2.x, bhi2.y};
                        oT[cb2] = __builtin_amdgcn_mfma_f32_32x32x16_bf16(__builtin_bit_cast(bf16x8, sw), __builtin_bit_cast(bf16x8, bw), oT[cb2], 0, 0, 0); }
            }
        }
#pragma unroll
        for (int db = 0; db < 4; ++db) {
#pragma unroll
            for (int g4 = 0; g4 < 4; ++g4) { const f32x4 dv = *(const f32x4*)(DEC + 32 * db + 8 * g4 + 4 * hi); St[db][4 * g4 + 0] *= dv[0]; St[db][4 * g4 + 1] *= dv[1]; St[db][4 * g4 + 2] *= dv[2]; St[db][4 * g4 + 3] *= dv[3]; }
#pragma unroll
            for (int ks = 0; ks < 4; ++ks) { const bf16x8 A = *(const bf16x8*)(KET + (32 * db + r32) * 144 + (16 * ks + 8 * hi) * 2);
                St[db] = __builtin_amdgcn_mfma_f32_32x32x16_bf16(A, Vf[ks], St[db], 0, 0, 0); }
        }
        if (PASS == 3) { bf16* od = (bf16*)(a.ws + WS_OF) + (size_t)dir * S_ * 1024;
#pragma unroll
            for (int cb2 = 0; cb2 < 2; ++cb2) { const int t = GLA_TOK(ci, 32 * cb2 + r32); bf16* op = od + (size_t)t * 1024 + head * 256 + 32 * wid + 8 * hi;
#pragma unroll
                for (int p = 0; p < 2; ++p) {
                    const unsigned ax = cvtpk(oT[cb2][8 * p + 0], oT[cb2][8 * p + 1]), ay = cvtpk(oT[cb2][8 * p + 2], oT[cb2][8 * p + 3]);
                    const unsigned bx = cvtpk(oT[cb2][8 * p + 4], oT[cb2][8 * p + 5]), by = cvtpk(oT[cb2][8 * p + 6], oT[cb2][8 * p + 7]);
                    auto r0 = __builtin_amdgcn_permlane32_swap(ax, bx, false, false); auto r1 = __builtin_amdgcn_permlane32_swap(ay, by, false, false);
                    const u32x4 w = {r0[0], r1[0], r0[1], r1[1]};
                    *(u32x4*)(op + 16 * p) = w; } } }
        __syncthreads();
    }
#undef GLA_LOAD
#undef GLA_TOK
    if (PASS == 1) { float* ds = (float*)(a.ws + WS_DS) + ((size_t)dh * 32 + sc) * 32768;
#pragma unroll
        for (int db = 0; db < 4; ++db)
#pragma unroll
            for (int r = 0; r < 16; ++r) ds[(32 * db + crow(r, hi)) * 256 + 32 * wid + r32] = St[db][r];
        if (r32 == 0) { float* dt = (float*)(a.ws + WS_DECT) + (dh * 32 + sc) * 128 + 16 * wid + 4 * hi;
#pragma unroll
            for (int j = 0; j < 8; ++j) dt[(j & 3) + 8 * (j >> 2)] = __expf(bsum[j]); } }
}
#undef DPP_ADD
__device__ __forceinline__ void gla_scan(const Args& a, int G) {
    const float* ds = (const float*)(a.ws + WS_DS); const float* dt = (const float*)(a.ws + WS_DECT); float* si = (float*)(a.ws + WS_SIN_ST);
    const int gt = blockIdx.x * NTHREADS + threadIdx.x, NGT = G * NTHREADS;
    for (int idx = gt; idx < 8 * 32768; idx += NGT) { const int dh = idx >> 15, el = idx & 32767, d = el >> 8;
        float x[32], dc[32];
#pragma unroll
        for (int sc = 0; sc < 32; ++sc) { x[sc] = ds[((size_t)dh * 32 + sc) * 32768 + el]; dc[sc] = dt[(dh * 32 + sc) * 128 + d]; }
        float s = 0.f;
#pragma unroll
        for (int sc = 0; sc < 32; ++sc) { si[((size_t)dh * 32 + sc) * 32768 + el] = s; s = dc[sc] * s + x[sc]; } }
}

__device__ __forceinline__ void finalize_mixed(const Args& a, int wave, int lane, int G) {
    unsigned char* mixed = a.ws + WS_MIX; float* sam = (float*)(a.ws + WS_SAM); const bf16* araw = (const bf16*)(a.ws + WS_ARAW); const float* assq = (const float*)(a.ws + WS_ASSQ); const bf16* proj = (const bf16*)(a.ws + WS_PROJ);
    const bf16* of = (const bf16*)(a.ws + WS_OF); const bf16* ob = of + (size_t)S_ * 1024;
    const int gw = blockIdx.x * NWAVES + wave, NGW = G * NWAVES; const int hi = lane >> 5, l31 = lane & 31;
    float anw[16], gnw[8];
#pragma unroll
    for (int i = 0; i < 2; ++i)
#pragma unroll
        for (int e = 0; e < 8; ++e) anw[i * 8 + e] = a.in[I_ANW][512 * i + lane * 8 + e];
#pragma unroll
    for (int e = 0; e < 8; ++e) gnw[e] = a.in[I_GNW][l31 * 8 + e];
    for (int t = gw; t < S_; t += NGW) {
        u32x4 va[2], vf[2], vb[2], vg[2];
#pragma unroll
        for (int i = 0; i < 2; ++i) va[i] = *(const GAS u32x4*)(araw + (size_t)t * 1024 + 512 * i + lane * 8);
#pragma unroll
        for (int j = 0; j < 2; ++j) { const int c = (2 * j + hi) * 256 + 8 * l31; vf[j] = *(const GAS u32x4*)(of + (size_t)t * 1024 + c); vb[j] = *(const GAS u32x4*)(ob + (size_t)t * 1024 + c); vg[j] = *(const GAS u32x4*)(proj + (size_t)t * PROJ_LD + C_GR + c); }
        const float tot = wave_sum(lane < 8 ? assq[t * 8 + lane] : 0.f);
        const float rstd = 1.f / sqrtf(tot * (1.f / 1024.f) + EPS_);
        float av[16], gv[16]; float mx = 0.f;
#pragma unroll
        for (int i = 0; i < 2; ++i) { const u32x4 v = va[i]; const float* w = anw + i * 8; float* o = av + i * 8;
            o[0] = bflo(v.x) * rstd * w[0]; o[1] = bfhi(v.x) * rstd * w[1]; o[2] = bflo(v.y) * rstd * w[2]; o[3] = bfhi(v.y) * rstd * w[3];
            o[4] = bflo(v.z) * rstd * w[4]; o[5] = bfhi(v.z) * rstd * w[5]; o[6] = bflo(v.w) * rstd * w[6]; o[7] = bfhi(v.w) * rstd * w[7]; }
#pragma unroll
        for (int j = 0; j < 2; ++j) { const u32x4 f = vf[j], b = vb[j], g = vg[j];
            float o8[8] = {bflo(f.x) + bflo(b.x), bfhi(f.x) + bfhi(b.x), bflo(f.y) + bflo(b.y), bfhi(f.y) + bfhi(b.y), bflo(f.z) + bflo(b.z), bfhi(f.z) + bfhi(b.z), bflo(f.w) + bflo(b.w), bfhi(f.w) + bfhi(b.w)};
            const float gg[8] = {bflo(g.x), bfhi(g.x), bflo(g.y), bfhi(g.y), bflo(g.z), bfhi(g.z), bflo(g.w), bfhi(g.w)};
            float ss = 0.f;
#pragma unroll
            for (int e = 0; e < 8; ++e) ss += o8[e] * o8[e];
            ss += WV_DPP(ss, 0x111, 0xF); ss += WV_DPP(ss, 0x112, 0xF); ss += WV_DPP(ss, 0x114, 0xF); ss += WV_DPP(ss, 0x118, 0xF); ss += WV_DPP(ss, 0x142, 0xA);
            const float slo = __builtin_bit_cast(float, __builtin_amdgcn_readlane(__builtin_bit_cast(int, ss), 31)), shi = __builtin_bit_cast(float, __builtin_amdgcn_readlane(__builtin_bit_cast(int, ss), 63));
            const float rs = 1.f / sqrtf((hi ? shi : slo) * (1.f / 256.f) + EPS_);
#pragma unroll
            for (int e = 0; e < 8; ++e) gv[j * 8 + e] = o8[e] * rs * gnw[e] * pg8::silu_f(gg[e]); }
#pragma unroll
        for (int e = 0; e < 16; ++e) mx = fmaxf(mx, fmaxf(fabsf(av[e]), fabsf(gv[e])));
        mx = wave_max(mx); const float inv = mx > 0.f ? 127.f / mx : 0.f;
        if (lane == 0) sam[t] = mx * (1.f / 127.f);
#pragma unroll
        for (int i = 0; i < 2; ++i) { u32x2 w; w.x = pk4_i8(av[i * 8 + 0] * inv, av[i * 8 + 1] * inv, av[i * 8 + 2] * inv, av[i * 8 + 3] * inv); w.y = pk4_i8(av[i * 8 + 4] * inv, av[i * 8 + 5] * inv, av[i * 8 + 6] * inv, av[i * 8 + 7] * inv);
            *(GAS u32x2*)(mixed + (size_t)t * DM + 512 * i + lane * 8) = w; }
#pragma unroll
        for (int j = 0; j < 2; ++j) { u32x2 w; w.x = pk4_i8(gv[j * 8 + 0] * inv, gv[j * 8 + 1] * inv, gv[j * 8 + 2] * inv, gv[j * 8 + 3] * inv); w.y = pk4_i8(gv[j * 8 + 4] * inv, gv[j * 8 + 5] * inv, gv[j * 8 + 6] * inv, gv[j * 8 + 7] * inv);
            *(GAS u32x2*)(mixed + (size_t)t * DM + 1024 + (2 * j + hi) * 256 + 8 * l31) = w; }
    }
}

__device__ __forceinline__ void router_block(const Args& a, unsigned char* lds, int tb) {
    const int tid = opaque_tid(), wid = __builtin_amdgcn_readfirstlane(tid >> 6), lane = tid & 63, l15 = lane & 15, l4 = lane >> 4;
    const bf16* h = (const bf16*)(a.ws + WS_H); const float* lw = a.in[I_LN2];
    unsigned char* xn2 = a.ws + WS_XN2; const bf16* wr = (const bf16*)(a.ws + WS_WR);
    char* At = (char*)lds;
    float* part = (float*)lds;
    float* rsl = (float*)(lds + 100352); int* cntl = (int*)(lds + 100352 + 256);
    pg8::f32x4 acc[4][3];
#pragma unroll
    for (int rb = 0; rb < 4; ++rb)
#pragma unroll
        for (int nb = 0; nb < 3; ++nb) acc[rb][nb] = (pg8::f32x4){0.f, 0.f, 0.f, 0.f};
    float ssq[8];
#pragma unroll
    for (int rr = 0; rr < 8; ++rr) ssq[rr] = 0.f;
    u32x4 hn[8];
#pragma unroll
    for (int rr = 0; rr < 8; ++rr) hn[rr] = *(const u32x4*)(h + ((size_t)tb * 64 + 8 * wid + rr) * DM + 8 * lane);
#pragma unroll 1
    for (int kc = 0; kc < 4; ++kc) {
        const f32x4 w0 = *(const f32x4*)(lw + kc * 512 + 8 * lane), w1 = *(const f32x4*)(lw + kc * 512 + 8 * lane + 4);
#pragma unroll
        for (int rr = 0; rr < 8; ++rr) { const int row = 8 * wid + rr; const size_t t = (size_t)tb * 64 + row;
            const u32x4 hv = hn[rr];
            const float f0 = bflo(hv.x), f1 = bfhi(hv.x), f2 = bflo(hv.y), f3 = bfhi(hv.y), f4 = bflo(hv.z), f5 = bfhi(hv.z), f6 = bflo(hv.w), f7 = bfhi(hv.w);
            ssq[rr] += (f0 * f0 + f1 * f1) + (f2 * f2 + f3 * f3) + (f4 * f4 + f5 * f5) + (f6 * f6 + f7 * f7);
            const float a0 = f0 * w0.x, a1 = f1 * w0.y, a2 = f2 * w0.z, a3 = f3 * w0.w, a4 = f4 * w1.x, a5 = f5 * w1.y, a6 = f6 * w1.z, a7 = f7 * w1.w;
            u32x4 p; p.x = pk2(a0, a1); p.y = pk2(a2, a3); p.z = pk2(a4, a5); p.w = pk2(a6, a7);
            *(u32x4*)(At + row * 1040 + (8 * lane) * 2) = p;
            u32x2 q8; q8.x = pg8::pk4_fp8(a0, a1, a2, a3); q8.y = pg8::pk4_fp8(a4, a5, a6, a7);
            *(u32x2*)(xn2 + t * XN2_P + kc * 512 + 8 * lane) = q8; }
        { const int kn = kc < 3 ? kc + 1 : 3;
#pragma unroll
          for (int rr = 0; rr < 8; ++rr) hn[rr] = *(const u32x4*)(h + ((size_t)tb * 64 + 8 * wid + rr) * DM + kn * 512 + 8 * lane); }
        bf16x8 B[2][3];
#pragma unroll
        for (int k2 = 0; k2 < 2; ++k2)
#pragma unroll
            for (int nb = 0; nb < 3; ++nb) B[k2][nb] = *(const bf16x8*)(wr + (size_t)(16 * nb + l15) * DM + kc * 512 + 32 * (2 * wid + k2) + 8 * l4);
        __syncthreads();
#pragma unroll
        for (int k2 = 0; k2 < 2; ++k2) { const int ks = 2 * wid + k2;
#pragma unroll
            for (int rb = 0; rb < 4; ++rb) { const bf16x8 A = *(const bf16x8*)(At + (16 * rb + l15) * 1040 + (32 * ks + 8 * l4) * 2);
#pragma unroll
                for (int nb = 0; nb < 3; ++nb) acc[rb][nb] = __builtin_amdgcn_mfma_f32_16x16x32_bf16(A, B[k2][nb], acc[rb][nb], 0, 0, 0); } }
        __syncthreads();
    }
#pragma unroll
    for (int rr = 0; rr < 8; ++rr) { const float s = wave_sum(ssq[rr]); if (lane == 0) rsl[8 * wid + rr] = 1.f / sqrtf(s * (1.f / DM) + EPS_); }
#pragma unroll
    for (int rb = 0; rb < 4; ++rb)
#pragma unroll
        for (int nb = 0; nb < 3; ++nb)
#pragma unroll
            for (int r = 0; r < 4; ++r) part[(wid * 64 + 16 * rb + 4 * l4 + r) * 48 + 16 * nb + l15] = acc[rb][nb][r];
    if (tid < 32) cntl[tid] = 0;
    __syncthreads();
    if (tid < 64) { const int token = tb * 64 + tid; const float rstd = rsl[tid];
        float gl[4];
#pragma unroll
        for (int n = 0; n < 4; ++n) { float s = 0.f;
#pragma unroll
            for (int w = 0; w < 8; ++w) s += part[(w * 64 + tid) * 48 + n];
            gl[n] = s * rstd + a.in[I_BG][n]; }
        int gs = 0; float gm = gl[0];
#pragma unroll
        for (int n = 1; n < 4; ++n) if (gl[n] > gm) { gm = gl[n]; gs = n; }
        float den = 0.f;
#pragma unroll
        for (int n = 0; n < 4; ++n) den += __expf(gl[n] - gm);
        const float gate = 1.f / den;
        float el[8];
#pragma unroll
        for (int j = 0; j < 8; ++j) { float s = 0.f;
#pragma unroll
            for (int w = 0; w < 8; ++w) s += part[(w * 64 + tid) * 48 + 4 + gs * 8 + j];
            el[j] = s * rstd + a.in[I_BR][gs * 8 + j]; }
        int i0 = 0; float v0 = el[0];
#pragma unroll
        for (int j = 1; j < 8; ++j) if (el[j] > v0) { v0 = el[j]; i0 = j; }
        int i1 = -1; float v1 = -3.0e38f;
#pragma unroll
        for (int j = 0; j < 8; ++j) if (j != i0 && el[j] > v1) { v1 = el[j]; i1 = j; }
        const float ex = __expf(v1 - v0), p0 = 1.f / (1.f + ex), p1 = ex * p0;
        int* te = (int*)(a.ws + WS_TOKE); float* tw = (float*)(a.ws + WS_TOKW); float* tr = (float*)(a.ws + WS_TOKR);
        te[token * 2] = gs * 8 + i0; te[token * 2 + 1] = gs * 8 + i1; tw[token * 2] = gate * p0; tw[token * 2 + 1] = gate * p1; tr[token] = rstd;
        atomicAdd(&cntl[gs * 8 + i0], 1); atomicAdd(&cntl[gs * 8 + i1], 1); }
    __syncthreads();
    if (tid < 32) ((int*)(a.ws + WS_CNT))[tb * 32 + tid] = cntl[tid];
    __syncthreads();
}
__device__ __forceinline__ void assign_block(const Args& a, unsigned char* lds, int tb) {
    const int tid = opaque_tid(), wid = __builtin_amdgcn_readfirstlane(tid >> 6), lane = tid & 63;
    const int* cnt = (const int*)(a.ws + WS_CNT); const int* te = (const int*)(a.ws + WS_TOKE); const float* tw = (const float*)(a.ws + WS_TOKW); const float* tr = (const float*)(a.ws + WS_TOKR);
    int* sdst = (int*)(a.ws + WS_SDST); float* sw = (float*)(a.ws + WS_SW); float* srs = (float*)(a.ws + WS_SRS); int* tile_e = (int*)(a.ws + WS_TILEE);
    int* L_tot = (int*)lds; int* L_bef = L_tot + 32; int* L_ps = L_bef + 32; int* L_base = L_ps + 40; int* L_e = L_base + 32; int* L_slot = L_e + 128;
    { int* L_pt = L_slot + 128; int* L_pb = L_pt + 512;
      const int e = tid & 31, seg = tid >> 5; int tot = 0, bef = 0;
#pragma unroll
      for (int i = 0; i < 16; ++i) { const int b = seg * 16 + i; const int c = cnt[b * 32 + e]; tot += c; bef += (b < tb) ? c : 0; }
      L_pt[tid] = tot; L_pb[tid] = bef; }
    __syncthreads();
    if (tid < 32) { int tot = 0, bef = 0;
#pragma unroll
        for (int s = 0; s < 16; ++s) { tot += L_slot[128 + s * 32 + tid]; bef += L_slot[128 + 512 + s * 32 + tid]; }
        L_tot[tid] = tot; L_bef[tid] = bef; }
    __syncthreads();
    if (tid == 0) { int p = 0; for (int e = 0; e < 32; ++e) { L_ps[e] = p; L_base[e] = p + L_bef[e]; p += (L_tot[e] + 255) & ~255; } L_ps[32] = p; }
    if (tid < 128) L_e[tid] = te[tb * 128 + tid];
    __syncthreads();
    if (tid < 128) { const int e = L_e[tid]; int rank = 0; for (int a2 = 0; a2 < tid; ++a2) rank += (L_e[a2] == e) ? 1 : 0;
        const int slot = L_base[e] + rank, token = tb * 64 + (tid >> 1), k = tid & 1; L_slot[tid] = slot;
        sdst[slot] = k * S_ + token; sw[slot] = tw[token * 2 + k]; srs[slot] = tr[token]; }
    __syncthreads();
    if (tb == 0) {
        for (int e = 0; e < 32; ++e) { const int st = L_ps[e] + L_tot[e], en = L_ps[e] + ((L_tot[e] + 255) & ~255);
            for (int s = st + tid; s < en; s += NTHREADS) { sdst[s] = -1; sw[s] = 0.f; srs[s] = 0.f; } }
        if (tid < 32) { const int t0 = L_ps[tid] >> 8, t1 = (L_ps[tid] + ((L_tot[tid] + 255) & ~255)) >> 8; for (int t = t0; t < t1; ++t) tile_e[t] = tid; }
        if (tid == 0) tile_e[MAX_TILES] = L_ps[32] >> 8;
    }
    __syncthreads();
}

template <int CLS> __device__ __forceinline__ void conv_share(const Args& a, int it0, int nitems, LAS unsigned char* lds, int wave, int lane, int G, int cls) {
    const bool split = (G % 16) == 0; const int b = blockIdx.x;
    if (!split) { if (cls == 0) titem_run<CLS>(a, it0, nitems, b * NWAVES + wave, G * NWAVES, (LAS float*)(lds + wave * 16384), lane); return; }
    if (((b >> 3) & 1) != cls) return;
    const int rank = (b >> 4) * 8 + (b & 7), half = nitems / 2;
    titem_run<CLS>(a, it0 + cls * half, cls ? nitems - half : half, rank * NWAVES + wave, (G / 2) * NWAVES, (LAS float*)(lds + wave * 16384), lane);
}

__global__ void __launch_bounds__(NTHREADS, 2) hymba_fwd(Args args) {
    extern __shared__ __attribute__((aligned(16))) unsigned char lds[];
    LAS unsigned char* ldsl = (LAS unsigned char*)lds;
    const int tid = opaque_tid(), lane = tid & 63, wave = __builtin_amdgcn_readfirstlane(tid >> 6);
    const int G = gridDim.x;
    unsigned char* ws = args.ws;
    for (int u = tid; u < (LDS_BYTES - LDSCTL_OFF) / 4; u += NTHREADS) ((LAS unsigned*)(ldsl + LDSCTL_OFF))[u] = 0u;
    __syncthreads();
    volatile LAS unsigned* MISC = (volatile LAS unsigned*)(ldsl + MISC_OFF);
    XcdBarrier bar = xcd_barrier_post((unsigned*)(ws + WS_CTL) + CW_BAR, MISC + 8);

    p0_prologue(args, ldsl, wave, lane, G);
    xcd_barrier(bar);
    { pg8::Gemm g{ws + WS_XN, ws + WS_WIN, DM, DM, DM, 128, 128, (size_t)256 * DM, (size_t)256 * DM}; pg8::StaticOrder S; S.init(S_, PROJ_LD, G, (int)blockIdx.x);
      pg8::EpiBf16Q E{(bf16*)(ws + WS_PROJ), PROJ_LD, (const float*)(ws + WS_SAX), (const float*)(ws + WS_CTL) + CW_CMAX_IN};
      pg8::gemm_phase<pg8::EpiBf16Q, pg8::StaticOrder, 2>(ldsl, g, S, E); }
    {
      const int nfull = (S_ / 256) * (PROJ_LD / 256) % G; const int first = (nfull != 0 && G - nfull >= 1) ? nfull : 0, nhost = G - first;
      __syncthreads();
      for (int s = (int)blockIdx.x - first; s >= 0 && s < 64; s += nhost) p0_strip(args, 145 + s, (LAS float*)(ldsl + wave * 16384), (LAS float*)(ldsl + TILEE_OFF + 1024), wave, lane); }
    xcd_barrier(bar);
    qk_norm_rope(args, wave, lane, G);
#if MK_STAGE >= 2
    __syncthreads();
    conv_share<1>(args, 0, 32 * 512, ldsl, wave, lane, G, 0);
    __syncthreads();
    for (int u = blockIdx.x; u < 256; u += G) gla_unit<1>(args, lds, u >> 7, (u >> 5) & 3, (u >> 7) ? 31 - (u & 31) : (u & 31));
    __syncthreads();
    conv_share<1>(args, 0, 32 * 512, ldsl, wave, lane, G, 1);
#endif
    xcd_barrier(bar);
#if MK_STAGE >= 2
    gla_scan(args, G);
#endif
    __syncthreads();
    conv_share<0>(args, 0, 32 * 512, ldsl, wave, lane, G, 0);
    __syncthreads();
    if (G == 256) {
        const int x = blockIdx.x & 7, i = blockIdx.x >> 3;
        for (int k = 0; k < 2; ++k) attn_unit(args, lds, (x >> 1) * 64 + k * 32 + i, x & 1); }
    else for (int u = blockIdx.x; u < 512; u += G) attn_unit(args, lds, u >> 1, u & 1);
    __syncthreads();
    conv_share<0>(args, 0, 32 * 512, ldsl, wave, lane, G, 1);
    xcd_barrier(bar);
#if MK_STAGE >= 2
    conv_share<0>(args, 32 * 512, 32 * 512, ldsl, wave, lane, G, 0);
    __syncthreads();
    for (int u = blockIdx.x; u < 256; u += G) gla_unit<3>(args, lds, u >> 7, (u >> 5) & 3, (u >> 7) ? 31 - (u & 31) : (u & 31));
    __syncthreads();
    conv_share<0>(args, 32 * 512, 32 * 512, ldsl, wave, lane, G, 1);
    xcd_barrier(bar);
#endif
    finalize_mixed(args, wave, lane, G);
    xcd_barrier(bar);
    { pg8::Gemm g{ws + WS_MIX, ws + WS_WOUT, DM, DM, DM, 128, 128, (size_t)256 * DM, (size_t)256 * DM}; pg8::StaticOrder S; S.init(S_, DM, G, (int)blockIdx.x);
      pg8::EpiResBf16Q E{(bf16*)(ws + WS_H), args.in[I_X], DM, (const float*)(ws + WS_SAM), (const float*)(ws + WS_CTL) + CW_CMAX_OUT};
      pg8::gemm_phase<pg8::EpiResBf16Q, pg8::StaticOrder, 2>(ldsl, g, S, E); }
#if MK_STAGE >= 3
    xcd_barrier(bar);
    for (int tb = blockIdx.x; tb < 256; tb += G) router_block(args, lds, tb);
    xcd_barrier(bar);
    for (int tb = blockIdx.x; tb < 256; tb += G) assign_block(args, lds, tb);
    xcd_barrier(bar);
    LAS int* tile_lds = (LAS int*)(ldsl + TILEE_OFF);
    if (tid <= MAX_TILES) tile_lds[tid] = ((const int*)(ws + WS_TILEE))[tid];
    __syncthreads();
    const int n_tiles = __builtin_amdgcn_readfirstlane(tile_lds[MAX_TILES]);
    { pg8::Gemm g{ws + WS_XN2, ws + WS_WGU, DM, XN2_P, 128, 128, 32768, 0, (size_t)256 * DM}; pg8::MoeOrder S; LAS int* tokl = (LAS int*)(ldsl + TILEE_OFF + 2048); S.init(n_tiles, 8, G, (int)blockIdx.x, tile_lds, tokl);
      { pg8::Unit u; const int* sdst = (const int*)(ws + WS_SDST);
        for (int i = 0; i < 12 && S.next(i, u); ++i) if (tid < 256) { const int d = sdst[u.pm * 256 + tid]; tokl[i * 256 + tid] = d < 0 ? 0 : (d & (S_ - 1)); } }
      __syncthreads();
      pg8::EpiSwiGLU E{ws + WS_HID, (const float*)(ws + WS_SRS)};
      pg8::gemm_phase<pg8::EpiSwiGLU, pg8::MoeOrder, 1, true>(ldsl, g, S, E); }
    xcd_barrier(bar);
    { pg8::Gemm g{ws + WS_HID, ws + WS_WD, DFF, 128, 128, 32768, 32768, (size_t)256 * DFF, (size_t)256 * DFF}; pg8::MoeOrder S; S.init(n_tiles, 8, G, (int)blockIdx.x, tile_lds);
      pg8::EpiMoeOut E{ws + WS_Y, (const int*)(ws + WS_SDST), (const float*)(ws + WS_SW)};
      pg8::gemm_phase<pg8::EpiMoeOut, pg8::MoeOrder, 1>(ldsl, g, S, E); }
    xcd_barrier(bar);
    { const int gt = blockIdx.x * NTHREADS + tid, NGT = G * NTHREADS; const unsigned char* Y0 = ws + WS_Y; const unsigned char* Y1 = Y0 + (size_t)S_ * DM; const bf16* H = (const bf16*)(ws + WS_H);
      typedef float f32x2_t __attribute__((ext_vector_type(2)));
      constexpr int NIT = S_ * DM / 8, UNR = 4;
      for (int i0 = gt; i0 < NIT; i0 += NGT * UNR) {
          u32x4 hv[UNR]; u32x2 y0[UNR], y1[UNR];
#pragma unroll
          for (int u = 0; u < UNR; ++u) { const int i = i0 + u * NGT; if (i < NIT) { hv[u] = *((const GAS u32x4*)H + i); y0[u] = *((const GAS u32x2*)Y0 + i); y1[u] = *((const GAS u32x2*)Y1 + i); } }
#pragma unroll
          for (int u = 0; u < UNR; ++u) { const int i = i0 + u * NGT; if (i < NIT) { GAS f32x4* o = (GAS f32x4*)args.out + 2 * (size_t)i;
              const f32x2_t a0 = __builtin_amdgcn_cvt_pk_f32_fp8(y0[u].x, false), a1 = __builtin_amdgcn_cvt_pk_f32_fp8(y0[u].x, true), a2 = __builtin_amdgcn_cvt_pk_f32_fp8(y0[u].y, false), a3 = __builtin_amdgcn_cvt_pk_f32_fp8(y0[u].y, true);
              const f32x2_t b0 = __builtin_amdgcn_cvt_pk_f32_fp8(y1[u].x, false), b1 = __builtin_amdgcn_cvt_pk_f32_fp8(y1[u].x, true), b2 = __builtin_amdgcn_cvt_pk_f32_fp8(y1[u].y, false), b3 = __builtin_amdgcn_cvt_pk_f32_fp8(y1[u].y, true);
              f32x4 r0, r1; r0.x = bflo(hv[u].x) + (a0.x + b0.x) * pg8::YUNSCALE; r0.y = bfhi(hv[u].x) + (a0.y + b0.y) * pg8::YUNSCALE; r0.z = bflo(hv[u].y) + (a1.x + b1.x) * pg8::YUNSCALE; r0.w = bfhi(hv[u].y) + (a1.y + b1.y) * pg8::YUNSCALE;
              r1.x = bflo(hv[u].z) + (a2.x + b2.x) * pg8::YUNSCALE; r1.y = bfhi(hv[u].z) + (a2.y + b2.y) * pg8::YUNSCALE; r1.z = bflo(hv[u].w) + (a3.x + b3.x) * pg8::YUNSCALE; r1.w = bfhi(hv[u].w) + (a3.y + b3.y) * pg8::YUNSCALE;
              o[0] = r0; o[1] = r1; } } } }
#endif
}

extern "C" void kernel_launch(void* const* d_in, const int* in_sizes, int n_in, void* d_out, int out_size, void* d_ws, size_t ws_size, hipStream_t stream) {
    static int grid = 0;
    if (grid == 0) {
        if (n_in != 21 || in_sizes[0] != S_ * DM || out_size != S_ * DM || ws_size < WS_END) { fprintf(stderr, "kernel_launch: unexpected shapes (n_in %d, in0 %d, out %d, ws %zu); nothing launched\n", n_in, n_in > 0 ? in_sizes[0] : -1, out_size, ws_size); grid = -1; return; }
        int dev = 0, cus = 0, per_cu = 0;
        if (hipGetDevice(&dev) != hipSuccess || hipDeviceGetAttribute(&cus, hipDeviceAttributeMultiprocessorCount, dev) != hipSuccess) { grid = -1; return; }
        if (hipFuncSetAttribute((const void*)hymba_fwd, hipFuncAttributeMaxDynamicSharedMemorySize, LDS_BYTES) != hipSuccess) { fprintf(stderr, "kernel_launch: hipFuncSetAttribute failed\n"); grid = -1; return; }
        if (hipOccupancyMaxActiveBlocksPerMultiprocessor(&per_cu, (const void*)hymba_fwd, NTHREADS, LDS_BYTES) != hipSuccess || per_cu < 1) { fprintf(stderr, "kernel_launch: occupancy query says %d blocks per CU\n", per_cu); (void)hipGetLastError(); grid = -1; return; }
        grid = cus;
    }
    if (grid < 0) return;
    (void)hipMemsetAsync((char*)d_ws + WS_CTL, 0, CTL_ZERO_BYTES, stream);
    Args a{};
    for (int i = 0; i < 21; ++i) a.in[i] = (const float*)d_in[i];
    a.out = (float*)d_out; a.ws = (unsigned char*)d_ws;
    hipLaunchKernelGGL(hymba_fwd, dim3(grid), dim3(NTHREADS), LDS_BYTES, stream, a);
}
```
